# Optimizing an MI355X kernel written in HIP

```python
import math
import jax, jax.numpy as jnp
from jax import lax
import numpy as np

D_MODEL = 2048
BATCH = 4
SEQ = 4096
DEPTH = 4

CHUNK = 64
MIX_W = D_MODEL // 2
N_BRANCH = 3
LRU_W = MIX_W
LRU_BLOCKS = 16
LRU_BW = LRU_W // LRU_BLOCKS
CONV_W = 4
LRU_C = 8.0
ATT_HEADS = 8
ATT_HD = MIX_W // ATT_HEADS
ATT_LEFT_CHUNKS = 8
ATT_BAND = (ATT_LEFT_CHUNKS + 1) * CHUNK
MAX_REL = 128
N_REL = 2 * MAX_REL + 1
SSM_W = MIX_W
SSM_GROUP = 16
SSM_G = SSM_W // SSM_GROUP
SSM_P = 64
FFN_HIDDEN = -(-8 * D_MODEL // (3 * 256)) * 256
IN_SPLITS = [LRU_W, LRU_W, MIX_W, MIX_W, MIX_W, SSM_W]
IN_W = sum(IN_SPLITS) + N_BRANCH * D_MODEL
NORM_EPS = 1e-6
MASK_VALUE = -1e30

kernel_name = "hybrid_gated_lru_chunkattn_s5_encoder"


def rmsnorm(x, g):
    xf = x.astype(jnp.float32)
    xf = xf * lax.rsqrt(jnp.mean(xf * xf, axis=-1, keepdims=True) + NORM_EPS)
    return xf.astype(x.dtype) * g


def causal_dwconv(x, w, b):
    s = x.shape[1]
    xp = jnp.pad(x, ((0, 0), (CONV_W - 1, 0), (0, 0)))
    y = b
    for k in range(CONV_W):
        y = y + xp[:, k:k + s] * w[k]
    return y


def _lin_op(e1, e2):
    a1, b1 = e1
    a2, b2 = e2
    return a1 * a2, a2 * b1 + b2


def _complex_lin_op(e1, e2):
    ar1, ai1, br1, bi1 = e1
    ar2, ai2, br2, bi2 = e2
    return (ar2 * ar1 - ai2 * ai1,
            ar2 * ai1 + ai2 * ar1,
            ar2 * br1 - ai2 * bi1 + br2,
            ar2 * bi1 + ai2 * br1 + bi2)


def rg_lru_branch(xin, gate_in, conv_w, conv_b, wa, ba, wx, bx, lam):
    b_, s_, _ = xin.shape
    xc = causal_dwconv(xin, conv_w, conv_b).astype(jnp.float32)
    xb = xc.reshape(b_, s_, LRU_BLOCKS, LRU_BW)
    r = jax.nn.sigmoid(jnp.einsum("bsnk,nkj->bsnj", xb, wa.astype(jnp.float32)).reshape(b_, s_, LRU_W) + ba)
    i = jax.nn.sigmoid(jnp.einsum("bsnk,nkj->bsnj", xb, wx.astype(jnp.float32)).reshape(b_, s_, LRU_W) + bx)
    log_a = -LRU_C * r * jax.nn.softplus(-lam.astype(jnp.float32))
    a = jnp.exp(log_a)
    inp = jnp.sqrt(-jnp.expm1(2.0 * log_a)) * (i * xc)
    h = lax.associative_scan(_lin_op, (a, inp), axis=1)[1]
    return (h * jax.nn.gelu(gate_in.astype(jnp.float32))).astype(xin.dtype)


def chunk_attention_branch(q, k, v, rel_bias):
    b_, s_, _ = q.shape
    n_c = s_ // CHUNK
    qc = q.reshape(b_, n_c, CHUNK, ATT_HEADS, ATT_HD)
    pad = ((0, 0), (ATT_LEFT_CHUNKS, 0), (0, 0), (0, 0), (0, 0))
    kp = jnp.pad(k.reshape(b_, n_c, CHUNK, ATT_HEADS, ATT_HD), pad)
    vp = jnp.pad(v.reshape(b_, n_c, CHUNK, ATT_HEADS, ATT_HD), pad)
    band_idx = jnp.arange(n_c)[:, None] + jnp.arange(ATT_LEFT_CHUNKS + 1)[None, :]
    kb = kp[:, band_idx].reshape(b_, n_c, ATT_BAND, ATT_HEADS, ATT_HD)
    vb = vp[:, band_idx].reshape(b_, n_c, ATT_BAND, ATT_HEADS, ATT_HD)
    scores = jnp.einsum("bcqhd,bckhd->bchqk", qc, kb).astype(jnp.float32) * (ATT_HD ** -0.5)
    q_pos = ATT_LEFT_CHUNKS * CHUNK + jnp.arange(CHUNK)
    k_pos = jnp.arange(ATT_BAND)
    rel = jnp.clip(q_pos[:, None] - k_pos[None, :], -MAX_REL, MAX_REL) + MAX_REL
    bias = rel_bias.astype(jnp.float32)[:, rel]
    key_abs = (jnp.arange(n_c)[:, None] - ATT_LEFT_CHUNKS) * CHUNK + k_pos[None, :]
    valid = key_abs >= 0
    scores = jnp.where(valid[None, :, None, None, :], scores + bias[None, None], MASK_VALUE)
    p = jax.nn.softmax(scores, axis=-1).astype(v.dtype)
    o = jnp.einsum("bchqk,bckhd->bcqhd", p, vb)
    return o.reshape(b_, s_, MIX_W)


def s5_branch(u, a_re, a_im, b_re, b_im, c_re, c_im, d, log_step):
    b_, s_, _ = u.shape
    uf = u.astype(jnp.float32)
    ug = uf.reshape(b_, s_, SSM_G, SSM_GROUP)
    a_re = a_re.astype(jnp.float32)
    a_im = a_im.astype(jnp.float32)
    step = jnp.exp(log_step.astype(jnp.float32))[:, None]
    mag = jnp.exp(a_re * step)
    ang = a_im * step
    lb_re = mag * jnp.cos(ang)
    lb_im = mag * jnp.sin(ang)
    den = a_re * a_re + a_im * a_im
    nr = lb_re - 1.0
    coef_re = (nr * a_re + lb_im * a_im) / den
    coef_im = (lb_im * a_re - nr * a_im) / den
    b_re = b_re.astype(jnp.float32)
    b_im = b_im.astype(jnp.float32)
    bb_re = coef_re[..., None] * b_re - coef_im[..., None] * b_im
    bb_im = coef_re[..., None] * b_im + coef_im[..., None] * b_re
    bu_re = jnp.einsum("bsgh,gph->bsgp", ug, bb_re)
    bu_im = jnp.einsum("bsgh,gph->bsgp", ug, bb_im)
    ar = jnp.broadcast_to(lb_re, bu_re.shape)
    ai = jnp.broadcast_to(lb_im, bu_re.shape)
    _, _, xs_re, xs_im = lax.associative_scan(_complex_lin_op, (ar, ai, bu_re, bu_im), axis=1)
    y = (jnp.einsum("bsgp,ghp->bsgh", xs_re, c_re.astype(jnp.float32))
         - jnp.einsum("bsgp,ghp->bsgh", xs_im, c_im.astype(jnp.float32)))
    y = y.reshape(b_, s_, SSM_W) + d.astype(jnp.float32) * uf
    return y.astype(u.dtype)


def setup_inputs(seed: int = 0) -> dict:
    key = jax.random.key(seed)
    ks = jax.random.split(key, 32)
    f32 = jnp.float32

    def nrm(k, shape, scale):
        return jax.random.normal(k, shape, f32) * scale

    u_lam = jax.random.uniform(ks[8], (DEPTH, LRU_W), f32, 0.9, 0.999)
    p_lam = u_lam ** (1.0 / LRU_C)
    lru_lambda = jnp.log(p_lam) - jnp.log1p(-p_lam)
    n_idx = jnp.arange(SSM_P, dtype=f32)
    return {
        "x": nrm(ks[0], (BATCH, SEQ, D_MODEL), 1.0),
        "norm_mix_g": 1.0 + nrm(ks[1], (DEPTH, D_MODEL), 0.01),
        "w_in": nrm(ks[2], (DEPTH, D_MODEL, IN_W), D_MODEL ** -0.5),
        "gate_bias": nrm(ks[3], (DEPTH, N_BRANCH, D_MODEL), 0.01),
        "lru_conv_w": nrm(ks[4], (DEPTH, CONV_W, LRU_W), CONV_W ** -0.5),
        "lru_conv_b": nrm(ks[5], (DEPTH, LRU_W), 0.01),
        "lru_wa": nrm(ks[6], (DEPTH, LRU_BLOCKS, LRU_BW, LRU_BW), LRU_BW ** -0.5),
        "lru_ba": nrm(ks[7], (DEPTH, LRU_W), 0.01),
        "lru_wx": nrm(ks[9], (DEPTH, LRU_BLOCKS, LRU_BW, LRU_BW), LRU_BW ** -0.5),
        "lru_bx": nrm(ks[10], (DEPTH, LRU_W), 0.01),
        "lru_lambda": lru_lambda,
        "attn_rel_bias": nrm(ks[11], (DEPTH, ATT_HEADS, N_REL), 0.1),
        "ssm_a_re": -0.5 + nrm(ks[12], (DEPTH, SSM_G, SSM_P), 0.01),
        "ssm_a_im": math.pi * n_idx + nrm(ks[13], (DEPTH, SSM_G, SSM_P), 0.01),
        "ssm_b_re": nrm(ks[14], (DEPTH, SSM_G, SSM_P, SSM_GROUP), (2 * SSM_GROUP) ** -0.5),
        "ssm_b_im": nrm(ks[15], (DEPTH, SSM_G, SSM_P, SSM_GROUP), (2 * SSM_GROUP) ** -0.5),
        "ssm_c_re": nrm(ks[16], (DEPTH, SSM_G, SSM_GROUP, SSM_P), (2 * SSM_P) ** -0.5),
        "ssm_c_im": nrm(ks[17], (DEPTH, SSM_G, SSM_GROUP, SSM_P), (2 * SSM_P) ** -0.5),
        "ssm_d": nrm(ks[18], (DEPTH, SSM_W), 1.0),
        "ssm_log_step": jax.random.uniform(ks[19], (DEPTH, SSM_G), f32, math.log(1e-3), math.log(1e-1)),
        "ssm_w_glu": nrm(ks[20], (DEPTH, SSM_W, D_MODEL), SSM_W ** -0.5),
        "w_branch": nrm(ks[21], (DEPTH, N_BRANCH, MIX_W, D_MODEL), MIX_W ** -0.5),
        "w_out": nrm(ks[22], (DEPTH, D_MODEL, D_MODEL), D_MODEL ** -0.5),
        "norm_ffn_g": 1.0 + nrm(ks[23], (DEPTH, D_MODEL), 0.01),
        "w_ffn_gate": nrm(ks[24], (DEPTH, D_MODEL, FFN_HIDDEN), D_MODEL ** -0.5),
        "w_ffn_up": nrm(ks[25], (DEPTH, D_MODEL, FFN_HIDDEN), D_MODEL ** -0.5),
        "w_ffn_down": nrm(ks[26], (DEPTH, FFN_HIDDEN, D_MODEL), FFN_HIDDEN ** -0.5),
        "norm_final_g": 1.0 + nrm(ks[27], (D_MODEL,), 0.01),
    }


def reference(x, norm_mix_g, w_in, gate_bias, lru_conv_w, lru_conv_b, lru_wa, lru_ba, lru_wx, lru_bx,
              lru_lambda, attn_rel_bias, ssm_a_re, ssm_a_im, ssm_b_re, ssm_b_im, ssm_c_re, ssm_c_im,
              ssm_d, ssm_log_step, ssm_w_glu, w_branch, w_out, norm_ffn_g, w_ffn_gate, w_ffn_up,
              w_ffn_down, norm_final_g):
    b_, s_, _ = x.shape
    split_pts = [int(p) for p in np.cumsum(IN_SPLITS)]
    for l in range(DEPTH):
        h = rmsnorm(x, norm_mix_g[l])
        proj = h @ w_in[l]
        lru_x, lru_gate, q, k, v, ssm_u, gates = jnp.split(proj, split_pts, axis=-1)
        y_a = rg_lru_branch(lru_x, lru_gate, lru_conv_w[l], lru_conv_b[l], lru_wa[l], lru_ba[l],
                            lru_wx[l], lru_bx[l], lru_lambda[l])
        y_b = chunk_attention_branch(q, k, v, attn_rel_bias[l])
        y_c = jax.nn.gelu(s5_branch(ssm_u, ssm_a_re[l], ssm_a_im[l], ssm_b_re[l], ssm_b_im[l],
                                    ssm_c_re[l], ssm_c_im[l], ssm_d[l], ssm_log_step[l]))
        br_a = y_a @ w_branch[l, 0]
        br_b = y_b @ w_branch[l, 1]
        br_c = (y_c @ w_branch[l, 2]) * jax.nn.sigmoid(y_c @ ssm_w_glu[l])
        g = jax.nn.sigmoid(gates.reshape(b_, s_, N_BRANCH, D_MODEL) + gate_bias[l])
        merged = g[:, :, 0] * br_a + g[:, :, 1] * br_b + g[:, :, 2] * br_c
        x = x + merged @ w_out[l]
        h = rmsnorm(x, norm_ffn_g[l])
        x = x + (jax.nn.silu(h @ w_ffn_gate[l]) * (h @ w_ffn_up[l])) @ w_ffn_down[l]
    return rmsnorm(x, norm_final_g)
```

```cpp
#include <hip/hip_runtime.h>
#include <cstdio>
#include <cstdint>
namespace pg8 {
#define PG8_LAS __attribute__((address_space(3)))
typedef unsigned short bf16_t;
typedef short bf16x8 __attribute__((ext_vector_type(8)));
typedef float f32x4 __attribute__((ext_vector_type(4)));
typedef unsigned u32x4 __attribute__((ext_vector_type(4)));
constexpr int BM = 256, BK = 64, HALF = 128, HTB = HALF * BK * 2  , STAGE_BYTES = 8 * HTB, NXCD = 8, WGM = 8;

__host__ __device__ __forceinline__ int lds_byte(int r, int c) { const int st = (r >> 4) * 2 + (c >> 5), rr = r & 15, cc = c & 31, ob = rr * 64 + cc * 2; return st * 1024 + (ob ^ (((ob >> 9) & 1) << 5)); }
__host__ __device__ __forceinline__ void stage_rc(int b, int& R, int& C) { const int st = b / 1024, sb = b % 1024, swz = sb ^ (((sb >> 9) & 1) << 5); R = (st >> 1) * 16 + swz / 64; C = (st & 1) * 32 + (swz % 64) / 2; }
__host__ __device__ __forceinline__ int perm32(int rho) { const int n = rho >> 4, i = rho & 15; return 8 * (i >> 2) + 4 * n + (i & 3); }

struct Unit { int pm, pn; };
struct Gemm { const bf16_t* A; const bf16_t* Bt; int M, N, K; };

struct StaticOrder {
    int nM, nN, nwg, G, c;
    __host__ __device__ void init(int M, int N, int G_, int c_) { nM = M / BM; nN = N / BM; nwg = nM * nN; G = G_; c = c_; }
    __host__ __device__ bool next(int i, Unit& u) const {
        const long L = (long)i * G + c; if (L >= nwg) return false;
        int wgid = (int)L; { const int q = nwg / NXCD, r = nwg % NXCD, xcd = wgid % NXCD, off = wgid / NXCD; wgid = (xcd < r ? xcd * (q + 1) : r * (q + 1) + (xcd - r) * q) + off; }
        const int nig = WGM * nN, gid = wgid / nig, fm = gid * WGM, gsz = (nM - fm) < WGM ? (nM - fm) : WGM;
        u.pm = fm + ((wgid % nig) % gsz); u.pn = (wgid % nig) / gsz; return true;
    }
    __device__ __forceinline__ void a_ready(const Unit&) const {}
    __device__ __forceinline__ void done(const Unit&) const {}
};

__device__ __forceinline__ unsigned cvt_pk_bf16(float lo, float hi) { unsigned r; asm volatile("v_cvt_pk_bf16_f32 %0, %1, %2" : "=v"(r) : "v"(lo), "v"(hi)); return r; }
__device__ __forceinline__ float ex2(float x) { return __builtin_amdgcn_exp2f(x); }
__device__ __forceinline__ float rcp(float x) { return __builtin_amdgcn_rcpf(x); }
__device__ __forceinline__ float sigmoidf_(float x) { return rcp(1.0f + ex2(-1.4426950408889634f * x)); }
__device__ __forceinline__ float gelu_tanh(float x) { const float u = x * (1.0f + 0.044715f * x * x); return x * rcp(1.0f + ex2(-2.302208198f * u)); }
__device__ __forceinline__ float silu_(float x) { return x * sigmoidf_(x); }
__device__ __forceinline__ float bf_lo(unsigned w) { return __uint_as_float(w << 16); }
__device__ __forceinline__ float bf_hi(unsigned w) { return __uint_as_float(w & 0xffff0000u); }

constexpr int LDP = 12288;
constexpr int GATE_COL = 6144;
constexpr float QSCALE = 0.12751743082459868f;

struct EpiIn {
    static constexpr bool PERM = true, AFTER_DRAIN = false;
    bf16_t* O; const float* gbias;
    template <int MODE> __device__ __forceinline__ void run(const f32x4 (&acc)[2][2][4][2], const Unit& u, int wr, int wc, int fr, int fq) const {
        const int row0 = u.pm * BM + wr * 64 + fr, col0 = u.pn * BM + wc * 32 + 8 * fq;
        f32x4 bv[2][2];
#pragma unroll
        for (int bj = 0; bj < 2; ++bj)
#pragma unroll
            for (int n = 0; n < 2; ++n) bv[bj][n] = (MODE == 3) ? *(const f32x4*)(gbias + (col0 - GATE_COL) + bj * HALF + 4 * n) : (f32x4){0.f, 0.f, 0.f, 0.f};
#pragma unroll
        for (int ai = 0; ai < 2; ++ai)
#pragma unroll
            for (int m = 0; m < 4; ++m) { bf16_t* rowp = O + (size_t)(row0 + ai * HALF + m * 16) * LDP + col0;
#pragma unroll
                for (int bj = 0; bj < 2; ++bj) { f32x4 v0 = acc[ai][bj][m][0], v1 = acc[ai][bj][m][1];
                    if (MODE == 1) {
#pragma unroll
                        for (int j = 0; j < 4; ++j) { v0[j] = gelu_tanh(v0[j]); v1[j] = gelu_tanh(v1[j]); }
                    } else if (MODE == 2) { v0 = v0 * QSCALE; v1 = v1 * QSCALE; }
                    else if (MODE == 3) { v0 = v0 + bv[bj][0]; v1 = v1 + bv[bj][1];
#pragma unroll
                        for (int j = 0; j < 4; ++j) { v0[j] = sigmoidf_(v0[j]); v1[j] = sigmoidf_(v1[j]); } }
                    u32x4 w; w.x = cvt_pk_bf16(v0[0], v0[1]); w.y = cvt_pk_bf16(v0[2], v0[3]); w.z = cvt_pk_bf16(v1[0], v1[1]); w.w = cvt_pk_bf16(v1[2], v1[3]);
                    *(u32x4*)(rowp + bj * HALF) = w; } }
    }
    __device__ __forceinline__ void operator()(const f32x4 (&acc)[2][2][4][2], const Unit& u, int wr, int wc, int fr, int fq) const {
        const int pn = u.pn;
        if (pn >= 24) run<3>(acc, u, wr, wc, fr, fq);
        else if (pn < 4 || pn >= 12) run<0>(acc, u, wr, wc, fr, fq);
        else if (pn < 8) run<1>(acc, u, wr, wc, fr, fq);
        else run<2>(acc, u, wr, wc, fr, fq);
    }
};

template <int MODE> struct EpiBr {
    static constexpr bool PERM = true, AFTER_DRAIN = false;
    const bf16_t* G; bf16_t* PB; bf16_t* SB;
    __device__ __forceinline__ void operator()(const f32x4 (&acc)[2][2][4][2], const Unit& u, int wr, int wc, int fr, int fq) const {
        const int row0 = u.pm * BM + wr * 64 + fr, col0 = u.pn * BM + wc * 32 + 8 * fq;
#pragma unroll
        for (int ai = 0; ai < 2; ++ai)
#pragma unroll
            for (int m = 0; m < 4; ++m) { const size_t row = (size_t)(row0 + ai * HALF + m * 16);
#pragma unroll
                for (int bj = 0; bj < 2; ++bj) { const int col = col0 + bj * HALF;
                    float v[8];
#pragma unroll
                    for (int j = 0; j < 4; ++j) { v[j] = acc[ai][bj][m][0][j]; v[4 + j] = acc[ai][bj][m][1][j]; }
                    u32x4 gw = (u32x4){0u, 0u, 0u, 0u}, pw = (u32x4){0u, 0u, 0u, 0u}, sw = (u32x4){0u, 0u, 0u, 0u};
                    if (MODE <= 2) gw = *(const u32x4*)(G + row * LDP + GATE_COL + 2048 * MODE + col);
                    if (MODE == 1 || MODE == 3) pw = *(const u32x4*)(PB + row * 2048 + col);
                    if (MODE == 3) sw = *(const u32x4*)(SB + row * 2048 + col);
                    float o[8];
#pragma unroll
                    for (int j = 0; j < 4; ++j) {
                        const float g0 = bf_lo(gw[j]), g1 = bf_hi(gw[j]), p0 = bf_lo(pw[j]), p1 = bf_hi(pw[j]), s0 = bf_lo(sw[j]), s1 = bf_hi(sw[j]);
                        if (MODE == 0) { o[2 * j] = g0 * v[2 * j]; o[2 * j + 1] = g1 * v[2 * j + 1]; }
                        if (MODE == 1) { o[2 * j] = p0 + g0 * v[2 * j]; o[2 * j + 1] = p1 + g1 * v[2 * j + 1]; }
                        if (MODE == 2) { o[2 * j] = g0 * sigmoidf_(v[2 * j]); o[2 * j + 1] = g1 * sigmoidf_(v[2 * j + 1]); }
                        if (MODE == 3) { o[2 * j] = p0 + s0 * v[2 * j]; o[2 * j + 1] = p1 + s1 * v[2 * j + 1]; }
                    }
                    u32x4 w; w.x = cvt_pk_bf16(o[0], o[1]); w.y = cvt_pk_bf16(o[2], o[3]); w.z = cvt_pk_bf16(o[4], o[5]); w.w = cvt_pk_bf16(o[6], o[7]);
                    *(u32x4*)((MODE == 2 ? SB : PB) + row * 2048 + col) = w; } }
    }
};

struct EpiRes {
    static constexpr bool PERM = false, AFTER_DRAIN = false;
    const float* base; float* out;
    __device__ __forceinline__ void operator()(const f32x4 (&acc)[2][2][4][2], const Unit& u, int wr, int wc, int fr, int fq) const {
        const int row0 = u.pm * BM + wr * 64 + fr, col0 = u.pn * BM + wc * 32 + 4 * fq;
#pragma unroll
        for (int ai = 0; ai < 2; ++ai)
#pragma unroll
            for (int m = 0; m < 4; ++m) { const size_t off = (size_t)(row0 + ai * HALF + m * 16) * 2048 + col0;
#pragma unroll
                for (int bj = 0; bj < 2; ++bj)
#pragma unroll
                    for (int n = 0; n < 2; ++n) { const f32x4 bs = *(const f32x4*)(base + off + bj * HALF + n * 16); *(f32x4*)(out + off + bj * HALF + n * 16) = bs + acc[ai][bj][m][n]; } }
    }
};

struct EpiSwiglu {
    static constexpr bool PERM = true, AFTER_DRAIN = false;
    bf16_t* Hd;
    __device__ __forceinline__ void operator()(const f32x4 (&acc)[2][2][4][2], const Unit& u, int wr, int wc, int fr, int fq) const {
        const int row0 = u.pm * BM + wr * 64 + fr, col0 = u.pn * HALF + wc * 32 + 8 * fq;
#pragma unroll
        for (int ai = 0; ai < 2; ++ai)
#pragma unroll
            for (int m = 0; m < 4; ++m) { bf16_t* rowp = Hd + (size_t)(row0 + ai * HALF + m * 16) * 5632 + col0;
                float o[8];
#pragma unroll
                for (int j = 0; j < 4; ++j) { o[j] = silu_(acc[ai][0][m][0][j]) * acc[ai][1][m][0][j]; o[4 + j] = silu_(acc[ai][0][m][1][j]) * acc[ai][1][m][1][j]; }
                u32x4 w; w.x = cvt_pk_bf16(o[0], o[1]); w.y = cvt_pk_bf16(o[2], o[3]); w.z = cvt_pk_bf16(o[4], o[5]); w.w = cvt_pk_bf16(o[6], o[7]);
                *(u32x4*)rowp = w; }
    }
};

template <class Epi, class Sched, bool ALIGN_EPI = false, bool SP2 = false>
__device__ __forceinline__ void gemm_phase(PG8_LAS unsigned char* lds, const Gemm g, const Sched& S, const Epi& E) {
    int tid_ = threadIdx.x; asm volatile("" : "+v"(tid_));
    const int tid = tid_, wid = __builtin_amdgcn_readfirstlane(tid >> 6), lane = tid & 63, wr = wid >> 2, wc = wid & 3, fr = lane & 15, fq = lane >> 4;
    const int K = g.K, nt = K / BK;
    unsigned voffA[2], voffB[2];
#pragma unroll
    for (int i = 0; i < 2; ++i) { int R, C; stage_rc(tid * 16 + i * 8192, R, C); const int Rb = Epi::PERM ? ((R & ~31) + perm32(R & 31)) : R;
        voffA[i] = (unsigned)(R * K + C) * 2u; voffB[i] = (unsigned)(Rb * K + C) * 2u; }
    const size_t kstep = (size_t)(BK * 2);
    const size_t hstep = (size_t)HALF * K * 2;
    const size_t tstep = 2 * hstep;
    const unsigned ldsw = (unsigned)wid * 1024u;
    const int aoff = lds_byte(wr * 64 + fr, fq * 8), boff = lds_byte(wc * 32 + fr, fq * 8);
#define PG8_SA(b, h) (((b) * 2 + (h)) * HTB)
#define PG8_SB(b, h) ((4 + (b) * 2 + (h)) * HTB)
#define PG8_STAGE(bufoff, gbase, voff) do { _Pragma("unroll") for (int _i = 0; _i < 2; ++_i) \
        __builtin_amdgcn_global_load_lds((const unsigned*)((const char*)(gbase) + (voff)[_i]), (PG8_LAS unsigned*)(lds + (bufoff) + ldsw + _i * 8192), 16, 0, 0); } while (0)
#define PG8_LDA(dst, b, h) do { _Pragma("unroll") for (int m = 0; m < 4; ++m) _Pragma("unroll") for (int k = 0; k < 2; ++k) dst[m][k] = *(const PG8_LAS bf16x8*)(lds + PG8_SA(b, h) + aoff + m * 2048 + k * 1024); } while (0)
#define PG8_LDB(dst, b, h) do { _Pragma("unroll") for (int n = 0; n < 2; ++n) _Pragma("unroll") for (int k = 0; k < 2; ++k) dst[n][k] = *(const PG8_LAS bf16x8*)(lds + PG8_SB(b, h) + boff + n * 2048 + k * 1024); } while (0)
#define PG8_MMA(ai, bj, At, Bt) do { __builtin_amdgcn_s_setprio(1); _Pragma("unroll") for (int m = 0; m < 4; ++m) _Pragma("unroll") for (int n = 0; n < 2; ++n) _Pragma("unroll") for (int k = 0; k < 2; ++k) \
        acc[ai][bj][m][n] = __builtin_amdgcn_mfma_f32_16x16x32_bf16(Bt[n][k], At[m][k], acc[ai][bj][m][n], 0, 0, 0); __builtin_amdgcn_s_setprio(0); } while (0)
#define PG8_WAIT_V(n) asm volatile("s_waitcnt vmcnt(" #n ")" ::: "memory")
#define PG8_WAIT_L(n) asm volatile("s_waitcnt lgkmcnt(" #n ")" ::: "memory")
#define PG8_BAR __builtin_amdgcn_s_barrier()
#define PG8_SCHED __builtin_amdgcn_sched_barrier(0)
    Unit cur, nxt; int ui = 0;
    if (!S.next(0, cur)) return;
    f32x4 acc[2][2][4][2];
#pragma unroll
    for (int a = 0; a < 2; ++a)
#pragma unroll
        for (int b = 0; b < 2; ++b)
#pragma unroll
            for (int m = 0; m < 4; ++m)
#pragma unroll
                for (int n = 0; n < 2; ++n) acc[a][b][m][n] = (f32x4){0.f, 0.f, 0.f, 0.f};
    bf16x8 At[4][2], B0[2][2], B1[2][2];
    const char* cA = (const char*)g.A + (size_t)cur.pm * tstep; const char* cB = (const char*)g.Bt + (size_t)cur.pn * tstep;
    S.a_ready(cur);
    if constexpr (SP2) {
        PG8_STAGE(PG8_SB(0, 0), cB, voffB); PG8_STAGE(PG8_SB(0, 1), cB + hstep, voffB); PG8_STAGE(PG8_SA(0, 0), cA, voffA); PG8_STAGE(PG8_SA(0, 1), cA + hstep, voffA);
        if (wr == 1) PG8_BAR;
        PG8_WAIT_V(2); PG8_BAR;
        PG8_STAGE(PG8_SB(1, 0), cB + kstep, voffB); PG8_STAGE(PG8_SA(1, 0), cA + kstep, voffA); PG8_STAGE(PG8_SB(1, 1), cB + hstep + kstep, voffB);
        PG8_WAIT_V(6); PG8_BAR;
    } else {
        PG8_STAGE(PG8_SB(0, 0), cB, voffB); PG8_STAGE(PG8_SA(0, 0), cA, voffA); PG8_STAGE(PG8_SB(0, 1), cB + hstep, voffB); PG8_STAGE(PG8_SA(0, 1), cA + hstep, voffA);
        if (wr == 1) PG8_BAR;
        PG8_WAIT_V(4); PG8_BAR;
        PG8_STAGE(PG8_SB(1, 0), cB + kstep, voffB); PG8_STAGE(PG8_SA(1, 0), cA + kstep, voffA); PG8_STAGE(PG8_SB(1, 1), cB + hstep + kstep, voffB);
        PG8_WAIT_V(6); PG8_BAR;
    }
    for (;;) {
        const bool has_next = S.next(ui + 1, nxt);
        const char* nA = has_next ? (const char*)g.A + (size_t)nxt.pm * tstep : cA; const char* nB = has_next ? (const char*)g.Bt + (size_t)nxt.pn * tstep : cB;
        for (int t = 0; t < nt; t += 2) {
            const bool last = (t == nt - 2);
            const char* a1 = cA + (size_t)(t + 1) * kstep;
            const char* a2 = last ? nA : cA + (size_t)(t + 2) * kstep; const char* b2 = last ? nB : cB + (size_t)(t + 2) * kstep;
            const char* a3 = a2 + kstep; const char* b3 = b2 + kstep;
            if (last && has_next) S.a_ready(nxt);
            if constexpr (SP2) {
            PG8_LDB(B0, 0, 0); PG8_LDB(B1, 0, 1); PG8_SCHED; PG8_LDA(At, 0, 0); PG8_STAGE(PG8_SA(1, 1), a1 + hstep, voffA);
            PG8_WAIT_V(8); PG8_WAIT_L(0); PG8_BAR; PG8_MMA(0, 0, At, B0); PG8_MMA(0, 1, At, B1); PG8_BAR; PG8_SCHED;
            PG8_LDA(At, 0, 1); PG8_STAGE(PG8_SB(0, 0), b2, voffB); PG8_STAGE(PG8_SB(0, 1), b2 + hstep, voffB); PG8_STAGE(PG8_SA(0, 0), a2, voffA);
            PG8_WAIT_V(8); PG8_WAIT_L(0); PG8_BAR; PG8_MMA(1, 0, At, B0); PG8_MMA(1, 1, At, B1); PG8_BAR; PG8_SCHED;
            PG8_LDB(B0, 1, 0); PG8_LDB(B1, 1, 1); PG8_SCHED; PG8_LDA(At, 1, 0); PG8_STAGE(PG8_SA(0, 1), a2 + hstep, voffA);
            PG8_WAIT_V(8); PG8_WAIT_L(0); PG8_BAR; PG8_MMA(0, 0, At, B0); PG8_MMA(0, 1, At, B1); PG8_BAR; PG8_SCHED;
            PG8_LDA(At, 1, 1); PG8_STAGE(PG8_SB(1, 0), b3, voffB); PG8_STAGE(PG8_SB(1, 1), b3 + hstep, voffB); PG8_STAGE(PG8_SA(1, 0), a3, voffA);
            PG8_WAIT_V(8); PG8_WAIT_L(0); PG8_BAR; PG8_MMA(1, 0, At, B0); PG8_MMA(1, 1, At, B1); PG8_BAR; PG8_SCHED;
            } else {
            PG8_LDB(B0, 0, 0); PG8_SCHED; PG8_LDA(At, 0, 0); PG8_STAGE(PG8_SA(1, 1), a1 + hstep, voffA);
            PG8_WAIT_L(8); PG8_BAR; PG8_WAIT_L(0); PG8_MMA(0, 0, At, B0); PG8_BAR; PG8_SCHED;
            PG8_LDB(B1, 0, 1); PG8_STAGE(PG8_SB(0, 0), b2, voffB);
            PG8_BAR; PG8_WAIT_L(0); PG8_MMA(0, 1, At, B1); PG8_BAR;
            PG8_LDA(At, 0, 1); PG8_STAGE(PG8_SA(0, 0), a2, voffA);
            PG8_BAR; PG8_WAIT_L(0); PG8_MMA(1, 0, At, B0); PG8_BAR; PG8_SCHED;
            PG8_STAGE(PG8_SB(0, 1), b2 + hstep, voffB);
            PG8_WAIT_V(6); PG8_BAR; PG8_MMA(1, 1, At, B1); PG8_BAR;
            PG8_LDB(B0, 1, 0); PG8_SCHED; PG8_LDA(At, 1, 0); PG8_STAGE(PG8_SA(0, 1), a2 + hstep, voffA);
            PG8_WAIT_L(8); PG8_BAR; PG8_WAIT_L(0); PG8_MMA(0, 0, At, B0); PG8_BAR; PG8_SCHED;
            PG8_LDB(B1, 1, 1); PG8_STAGE(PG8_SB(1, 0), b3, voffB);
            PG8_BAR; PG8_WAIT_L(0); PG8_MMA(0, 1, At, B1); PG8_BAR;
            PG8_LDA(At, 1, 1); PG8_STAGE(PG8_SA(1, 0), a3, voffA);
            PG8_BAR; PG8_WAIT_L(0); PG8_MMA(1, 0, At, B0); PG8_BAR; PG8_SCHED;
            PG8_STAGE(PG8_SB(1, 1), b3 + hstep, voffB);
            PG8_WAIT_V(6); PG8_BAR; PG8_MMA(1, 1, At, B1); PG8_BAR;
            }
        }
        if constexpr (ALIGN_EPI) { if (wr == 0) PG8_BAR; }
        if constexpr (!Epi::AFTER_DRAIN) { E(acc, cur, wr, wc, fr, fq); S.done(cur); }
        if (!has_next) break;
#pragma unroll
        for (int a = 0; a < 2; ++a)
#pragma unroll
            for (int b = 0; b < 2; ++b)
#pragma unroll
                for (int m = 0; m < 4; ++m)
#pragma unroll
                    for (int n = 0; n < 2; ++n) acc[a][b][m][n] = (f32x4){0.f, 0.f, 0.f, 0.f};
        cur = nxt; cA = nA; cB = nB; ++ui;
        if constexpr (ALIGN_EPI) { if (wr == 1) PG8_BAR; }
    }
    PG8_WAIT_V(0);
    if constexpr (!ALIGN_EPI) { if (wr == 0) PG8_BAR; }
    PG8_BAR;
    if constexpr (Epi::AFTER_DRAIN) { E.fused(acc, cur, wr, wc, fr, fq, lds, wid, lane); S.done(cur); }
#undef PG8_SA
#undef PG8_SB
#undef PG8_STAGE
#undef PG8_LDA
#undef PG8_LDB
#undef PG8_MMA
#undef PG8_WAIT_V
#undef PG8_WAIT_L
#undef PG8_BAR
#undef PG8_SCHED
}
}
#define GAS __attribute__((address_space(1)))
#define LAS __attribute__((address_space(3)))
typedef unsigned short bf16;
typedef unsigned v4u __attribute__((ext_vector_type(4)));
typedef float f32x4 __attribute__((ext_vector_type(4)));
typedef short bf16x8 __attribute__((ext_vector_type(8)));
typedef GAS unsigned gu32;
typedef GAS unsigned long long gu64;
#define RLX_AGENT __ATOMIC_RELAXED, __HIP_MEMORY_SCOPE_AGENT
#define LDS_WAIT() asm volatile("s_waitcnt lgkmcnt(0)" ::: "memory")
#define VM_WAIT() asm volatile("s_waitcnt vmcnt(0)" ::: "memory")
__device__ __forceinline__ unsigned long long rt() { return __builtin_amdgcn_s_memrealtime(); }
__device__ __forceinline__ unsigned f2bf(float f) { unsigned u = __builtin_bit_cast(unsigned, f); return (u + 0x7fffu + ((u >> 16) & 1u)) >> 16; }
__device__ __forceinline__ unsigned pk2(float lo, float hi) { return f2bf(lo) | (f2bf(hi) << 16); }

#define XB_TMO      128
#define XB_XCNT(j)  (256  + 64 * (j))
#define XB_XSUB(j)  (1280 + 64 * (j))
#define XB_XGEN(j)  (2304 + 64 * (j))
#define XB_TOP      3328
#define XB_TOPGEN   3392
#define XCD_BAR_WORDS 3456
#define XB_SPIN_CAP (1u << 18)

__device__ __forceinline__ unsigned xb_ld(unsigned* p)              { return __hip_atomic_load(p, __ATOMIC_RELAXED, __HIP_MEMORY_SCOPE_AGENT); }
__device__ __forceinline__ unsigned xb_add(unsigned* p, unsigned v) { return __hip_atomic_fetch_add(p, v, __ATOMIC_RELAXED, __HIP_MEMORY_SCOPE_AGENT); }
__device__ __forceinline__ unsigned xb_xcc_id() { return (unsigned)__builtin_amdgcn_s_getreg((3 << 11) | 20) & 0xFu; }
#define XB_SPIN(cond, bar) do { unsigned _sp = 0; while (cond) { __builtin_amdgcn_s_sleep(1); \
    if ((++_sp & 255u) == 0u) { if (xb_ld(&(bar)[XB_TMO])) break; if (_sp > XB_SPIN_CAP) { atomicAdd(&(bar)[XB_TMO], 1u); break; } } } } while (0)

struct XcdBarrier {
    unsigned* bar; unsigned x;
    volatile LAS unsigned* st;
};

__device__ __forceinline__ XcdBarrier xcd_barrier_post(unsigned* bar, volatile LAS unsigned* st) {
    XcdBarrier b; b.bar = bar; b.x = xb_xcc_id(); b.st = st;
    if (threadIdx.x == 0) (void)xb_add(&bar[XB_XCNT(b.x)], 1u);
    return b;
}
__device__ __forceinline__ void xcd_barrier_complete(unsigned* bar, unsigned x, unsigned& nloc, unsigned& nx) {
    const unsigned G = gridDim.x * gridDim.y * gridDim.z;
    unsigned sum, cnt, mine, sp = 0u;
    for (;;) {
        sum = 0u; cnt = 0u; mine = 0u;
#pragma unroll
        for (unsigned j = 0; j < 16; ++j) { const unsigned c = xb_ld(&bar[XB_XCNT(j)]); sum += c; cnt += (c > 0u) ? 1u : 0u; mine = (j == x) ? c : mine; }
        if (sum == G) break;
        __builtin_amdgcn_s_sleep(1);
        if ((++sp & 255u) == 0u) { if (xb_ld(&bar[XB_TMO])) break; if (sp > XB_SPIN_CAP) { atomicAdd(&bar[XB_TMO], 1u); break; } }
    }
    nloc = mine > 0u ? mine : 1u; nx = cnt > 0u ? cnt : 1u;
}

__device__ __forceinline__ void xcd_barrier(const XcdBarrier& b) {
    asm volatile("s_waitcnt vmcnt(0)" ::: "memory");
    __syncthreads();
    if (threadIdx.x == 0) {
        unsigned* bar = b.bar;
        __builtin_amdgcn_s_waitcnt(0);
        unsigned nloc = b.st[0], nx = b.st[1];
        if (nloc == 0u) { xcd_barrier_complete(bar, b.x, nloc, nx); b.st[0] = nloc; b.st[1] = nx; }
        const unsigned old = xb_add(&bar[XB_XSUB(b.x)], 1u);
        const unsigned gen = old / nloc;
        if (old + 1u == (gen + 1u) * nloc) {
            __builtin_amdgcn_fence(__ATOMIC_RELEASE, "agent");
            asm volatile("s_waitcnt vmcnt(0)" ::: "memory");
            const unsigned og = xb_add(&bar[XB_TOP], 1u);
            const unsigned tg = og / nx;
            if (og + 1u == (tg + 1u) * nx) xb_add(&bar[XB_TOPGEN], 1u);
            else XB_SPIN(xb_ld(&bar[XB_TOPGEN]) == tg, bar);
            __builtin_amdgcn_fence(__ATOMIC_ACQUIRE, "agent");
            xb_add(&bar[XB_XGEN(b.x)], 1u);
            asm volatile("s_waitcnt vmcnt(0)" ::: "memory");
        } else {
            XB_SPIN(xb_ld(&bar[XB_XGEN(b.x)]) == gen, bar);
            __builtin_amdgcn_fence(__ATOMIC_ACQUIRE, "agent");
            asm volatile("s_waitcnt vmcnt(0)" ::: "memory");
        }
    }
    __syncthreads();
}

constexpr int NWAVES = 8;
constexpr int BATCH = 4, SEQ = 4096, DM = 2048, DEPTH = 4, MIXW = 1024, INW = 12288, FFH = 5632;
constexpr int M = BATCH * SEQ;
constexpr int LDP = INW;
constexpr int COL_LX = 0, COL_LG = 1024, COL_Q = 2048, COL_K = 3072, COL_V = 4096, COL_U = 5120, COL_G = 6144;
constexpr float NORM_EPS = 1e-6f;
constexpr float LOG2E = 1.4426950408889634f;

constexpr size_t MiB = 1u << 20;
constexpr size_t WS_CTL = 0, CTL_ZERO_BYTES = 1 * MiB;
constexpr size_t WS_PAR = 1 * MiB;
constexpr size_t WS_WIN = 9 * MiB;
constexpr size_t WS_WBR = WS_WIN + 192 * MiB;
constexpr size_t WS_WOUT = WS_WBR + 64 * MiB;
constexpr size_t WS_WGU = WS_WOUT + 32 * MiB;
constexpr size_t WS_WDN = WS_WGU + 176 * MiB;
constexpr size_t WS_H = WS_WDN + 88 * MiB;
constexpr size_t WS_PROJ = WS_H + 64 * MiB;
constexpr size_t WS_YA = WS_PROJ + 384 * MiB, WS_YB = WS_YA + 32 * MiB, WS_YC = WS_YB + 32 * MiB;
constexpr size_t WS_PB = WS_YC + 32 * MiB, WS_SB = WS_PB + 64 * MiB;
constexpr size_t WS_END = WS_SB + 64 * MiB;
constexpr int P_GMIX = 0, P_GBIAS = 2048, P_CONVW = 8192, P_CONVB = 12288, P_BA = 13312, P_BX = 14336, P_LAM = 15360, P_RELB = 16384, P_ARE = 18688, P_AIM = 22784, P_D = 26880, P_LOGSTEP = 27904,
              P_GFFN = 28160, P_WA = 30208, P_WX = 95744, P_BRE = 161280, P_BIM = 226816, P_CRE = 292352, P_CIM = 357888, P_GFIN = 423424, PAR_STRIDE = 425984;
static_assert((size_t)DEPTH * PAR_STRIDE * 4 <= 8 * MiB, "PAR");
constexpr int CW_BAR = 4096;
static_assert((CW_BAR + XCD_BAR_WORDS) * 4 <= (int)CTL_ZERO_BYTES, "CTL");

constexpr int RING_OFF = 0, RING_BYTES = 131072;
constexpr int LDSCTL_OFF = RING_BYTES, MISC_OFF = LDSCTL_OFF + 320;
constexpr int LDS_BYTES = 147456;

typedef float f32x16 __attribute__((ext_vector_type(16)));
typedef short s16x4 __attribute__((ext_vector_type(4)));
typedef unsigned u32x2 __attribute__((ext_vector_type(2)));
using pg8::ex2; using pg8::rcp;

__device__ __forceinline__ float wave_sum(float v) {
#pragma unroll
    for (int o = 1; o < 64; o <<= 1) v += __shfl_xor(v, o);
    return v;
}
__device__ __forceinline__ unsigned cvtpk(float lo, float hi) { unsigned r; asm volatile("v_cvt_pk_bf16_f32 %0, %1, %2" : "=v"(r) : "v"(lo), "v"(hi)); return r; }
__device__ __forceinline__ float bf2f(bf16 v) { return __uint_as_float(((unsigned)v) << 16); }
__device__ __forceinline__ bf16 f2bf16(float f) { return (bf16)(cvtpk(f, 0.f) & 0xffffu); }

template <class F>
__device__ __forceinline__ void transpose_item(const float* W, int K, int N, bf16* WT, F drow, LAS float* scr, int item, int lane) {
    const int nblk = N / 32, kb = item / nblk, nb = item % nblk, k0 = 64 * kb, n0 = 32 * nb;
#pragma unroll 8
    for (int i = 0; i < 32; ++i) { const int kk = 2 * i + (lane >> 5); scr[kk * 33 + (lane & 31)] = W[(size_t)(k0 + kk) * N + n0 + (lane & 31)]; }
    LDS_WAIT(); asm volatile("" ::: "memory");
    const int c = lane & 7;
    const int r0 = drow(n0);
#pragma unroll
    for (int j = 0; j < 4; ++j) { const int n = (lane >> 3) + 8 * j; const LAS float* s = scr + (8 * c) * 33 + n;
        v4u o; o.x = cvtpk(s[0 * 33], s[1 * 33]); o.y = cvtpk(s[2 * 33], s[3 * 33]); o.z = cvtpk(s[4 * 33], s[5 * 33]); o.w = cvtpk(s[6 * 33], s[7 * 33]);
        *(GAS v4u*)(WT + (size_t)(r0 + n) * K + k0 + 8 * c) = o; }
    LDS_WAIT(); asm volatile("" ::: "memory");
}
struct RowId { __device__ __forceinline__ int operator()(int n) const { return n; } };
struct RowGU { int half; __device__ __forceinline__ int operator()(int n) const { return 256 * (n >> 7) + 128 * half + (n & 127); } };

__device__ __forceinline__ void rms_row_bf16(const float* xrow, const float* g, bf16* orow, int lane) {
    const GAS f32x4* xr = (const GAS f32x4*)xrow + lane; const GAS f32x4* gr = (const GAS f32x4*)g + lane;
    f32x4 v[8]; float s = 0.f;
#pragma unroll
    for (int j = 0; j < 8; ++j) { v[j] = xr[64 * j]; s += (v[j].x * v[j].x + v[j].y * v[j].y) + (v[j].z * v[j].z + v[j].w * v[j].w); }
    const float r = 1.0f / sqrtf(wave_sum(s) * (1.0f / DM) + NORM_EPS);
    GAS u32x2* o8 = (GAS u32x2*)orow + lane;
#pragma unroll
    for (int j = 0; j < 8; ++j) { const f32x4 gg = gr[64 * j]; u32x2 w; w.x = cvtpk(v[j].x * r * gg.x, v[j].y * r * gg.y); w.y = cvtpk(v[j].z * r * gg.z, v[j].w * r * gg.w); o8[64 * j] = w; }
}
__device__ __forceinline__ void rms_row_f32(float* xrow, const float* g, int lane) {
    GAS f32x4* xr = (GAS f32x4*)xrow + lane; const GAS f32x4* gr = (const GAS f32x4*)g + lane;
    f32x4 v[8]; float s = 0.f;
#pragma unroll
    for (int j = 0; j < 8; ++j) { v[j] = xr[64 * j]; s += (v[j].x * v[j].x + v[j].y * v[j].y) + (v[j].z * v[j].z + v[j].w * v[j].w); }
    const float r = 1.0f / sqrtf(wave_sum(s) * (1.0f / DM) + NORM_EPS);
#pragma unroll
    for (int j = 0; j < 8; ++j) { const f32x4 gg = gr[64 * j]; xr[64 * j] = (v[j] * r) * gg; }
}

namespace att {
constexpr size_t SHM_V = 64 * 128 * 2, SHM_K = 64 * 128 * 2;
constexpr int OFF_WS = 2 * SHM_V + 2 * SHM_K, OFF_BT = OFF_WS + NWAVES * 64 * 4, ATT_LDS = OFF_BT + 320 * 4;
#define KSWZ(row, colB) ((row) * 256 + ((colB) ^ (((row) & 7) << 4)))
#define SBAR() __builtin_amdgcn_sched_barrier(0)
__device__ __forceinline__ int crow(int r, int hi) { return (r & 3) + 8 * (r >> 2) + 4 * hi; }
__device__ __forceinline__ void qkt(f32x16& p0, f32x16& p1, const char* Ks, const bf16x8* qr, int r32, int hi) {
    p0 = f32x16{}; p1 = f32x16{};
#pragma unroll
    for (int d0 = 0; d0 < 8; ++d0) { const int cb = (d0 * 16 + hi * 8) * 2;
        const bf16x8 b0 = *reinterpret_cast<const bf16x8*>(Ks + KSWZ(r32, cb));
        const bf16x8 b1 = *reinterpret_cast<const bf16x8*>(Ks + KSWZ(32 + r32, cb));
        p0 = __builtin_amdgcn_mfma_f32_32x32x16_bf16(b0, qr[d0], p0, 0, 0, 0);
        p1 = __builtin_amdgcn_mfma_f32_32x32x16_bf16(b1, qr[d0], p1, 0, 0, 0); }
}
__device__ __forceinline__ int v_st(int k, int c) { const int kk = (k & ~0xC) | ((k & 4) << 1) | ((k & 8) >> 1); return ((kk >> 3) * 4 + (c >> 5)) * 512 + ((kk & 7) * 32 + (c & 31)) * 2; }
__device__ __forceinline__ int v_rd_base(int lane) { return ((lane & 3) << 3) | (((lane >> 2) & 3) << 6) | (((lane >> 4) & 1) << 5) | (((lane >> 5) & 1) << 8); }
constexpr int v_rd_off(int d0, int ks, int half) { return d0 * 512 + ks * 4096 + half * 2048; }
template <int OFF> __device__ __forceinline__ s16x4 tr_read(int vb) {
    s16x4 r; asm volatile("ds_read_b64_tr_b16 %0, %1 offset:%2" : "=&v"(r) : "v"(vb), "i"(OFF) : "memory"); return r;
}
template <int D0> __device__ __forceinline__ void pv_one(f32x16& od, int vb, bf16x8 pa0, bf16x8 pa1, bf16x8 pa2, bf16x8 pa3) {
    const s16x4 l0 = tr_read<v_rd_off(D0, 0, 0)>(vb), h0 = tr_read<v_rd_off(D0, 0, 1)>(vb), l1 = tr_read<v_rd_off(D0, 1, 0)>(vb), h1 = tr_read<v_rd_off(D0, 1, 1)>(vb);
    const s16x4 l2 = tr_read<v_rd_off(D0, 2, 0)>(vb), h2 = tr_read<v_rd_off(D0, 2, 1)>(vb), l3 = tr_read<v_rd_off(D0, 3, 0)>(vb), h3 = tr_read<v_rd_off(D0, 3, 1)>(vb);
    asm volatile("s_waitcnt lgkmcnt(0)" ::: "memory"); SBAR();
#define PK(L, H) (bf16x8){L[0], L[1], L[2], L[3], H[0], H[1], H[2], H[3]}
    od = __builtin_amdgcn_mfma_f32_32x32x16_bf16(pa0, PK(l0, h0), od, 0, 0, 0);
    od = __builtin_amdgcn_mfma_f32_32x32x16_bf16(pa1, PK(l1, h1), od, 0, 0, 0);
    od = __builtin_amdgcn_mfma_f32_32x32x16_bf16(pa2, PK(l2, h2), od, 0, 0, 0);
    od = __builtin_amdgcn_mfma_f32_32x32x16_bf16(pa3, PK(l3, h3), od, 0, 0, 0);
#undef PK
}
__device__ __forceinline__ void tile_compute(f32x16 (&o)[4], float& m_reg, float& l_reg, const bf16x8 (&qr)[8], const char* Kbuf, int vb, const LAS float* bt, LAS float* al_l,
                                             int dc  , int qi  , int r32, int hi) {
    f32x16 p0, p1;
    qkt(p0, p1, Kbuf, qr, r32, hi);
    if (dc >= 3) { const float bc = bt[256];
#pragma unroll
        for (int r = 0; r < 16; ++r) { p0[r] += bc; p1[r] += bc; } }
    else { const LAS float* bp = bt + (64 * dc + qi + 128 - 4 * hi - 59);
#pragma unroll
        for (int r = 0; r < 16; ++r) p0[r] += bp[59 - ((r & 3) + 8 * (r >> 2))];
        SBAR();
#pragma unroll
        for (int r = 0; r < 16; ++r) p1[r] += bp[27 - ((r & 3) + 8 * (r >> 2))];
        SBAR(); }
    float pmax = p0[0];
#pragma unroll
    for (int r = 1; r < 16; ++r) pmax = fmaxf(pmax, p0[r]);
#pragma unroll
    for (int r = 0; r < 16; ++r) pmax = fmaxf(pmax, p1[r]);
    pmax = fmaxf(pmax, __shfl_xor(pmax, 32));
    const float mn = fmaxf(m_reg, pmax), alpha = ex2(m_reg - mn); m_reg = mn;
    float ps = 0.f;
#pragma unroll
    for (int r = 0; r < 16; ++r) { p0[r] = ex2(p0[r] - mn); p1[r] = ex2(p1[r] - mn); ps += p0[r] + p1[r]; }
    ps += __shfl_xor(ps, 32);
    l_reg = l_reg * alpha + ps;
    if (__any(alpha < 1.f)) { if (hi == 0) al_l[r32] = alpha; asm volatile("s_waitcnt lgkmcnt(0)" ::: "memory");
#pragma unroll
        for (int r = 0; r < 16; ++r) { const float a = al_l[crow(r, hi)];
#pragma unroll
            for (int d = 0; d < 4; ++d) o[d][r] *= a; }
        asm volatile("s_waitcnt lgkmcnt(0)" ::: "memory"); }
    bf16x8 pa0, pa1, pa2, pa3;
#define PK4(P, BASE, OUT) do { unsigned a0 = cvtpk(P[BASE + 0], P[BASE + 1]), a1 = cvtpk(P[BASE + 2], P[BASE + 3]);   \
    unsigned b0 = cvtpk(P[BASE + 4], P[BASE + 5]), b1 = cvtpk(P[BASE + 6], P[BASE + 7]);                              \
    auto r0 = __builtin_amdgcn_permlane32_swap(a0, b0, false, false); auto r1 = __builtin_amdgcn_permlane32_swap(a1, b1, false, false); \
    v4u w = {r0[0], r1[0], r0[1], r1[1]}; OUT = *reinterpret_cast<bf16x8*>(&w); } while (0)
    PK4(p0, 0, pa0); PK4(p0, 8, pa1); PK4(p1, 0, pa2); PK4(p1, 8, pa3);
#undef PK4
    pv_one<0>(o[0], vb, pa0, pa1, pa2, pa3); pv_one<1>(o[1], vb, pa0, pa1, pa2, pa3); pv_one<2>(o[2], vb, pa0, pa1, pa2, pa3); pv_one<3>(o[3], vb, pa0, pa1, pa2, pa3);
}

__device__ __forceinline__ void attn_unit(int b, int h, int qb, const bf16* __restrict__ proj, bf16* __restrict__ yb, const float* __restrict__ relb  , char* lds) {
    int tid_ = threadIdx.x; asm volatile("" : "+v"(tid_));
    const int tid = tid_, wid = tid >> 6, lane = tid & 63, r32 = lane & 31, hi = lane >> 5;
    char* V_lds = lds; char* K_lds = lds + 2 * SHM_V;
    LAS float* wsw = (LAS float*)(lds + OFF_WS) + wid * 64; LAS float* li_l = wsw; LAS float* al_l = wsw + 32;
    LAS float* bt = (LAS float*)(lds + OFF_BT);
    for (int i = tid; i < 320; i += NWAVES * 64) bt[i] = relb[i < 256 ? i : 256] * LOG2E;
    float m_reg = -1e30f, l_reg = 0.f; f32x16 o[4] = {}; bf16x8 qr[8];
    const size_t rowq = (size_t)b * SEQ + (size_t)qb * 256 + wid * 32 + r32;
    const bf16* Qw = proj + rowq * LDP + COL_Q + h * 128 + hi * 8;
#pragma unroll
    for (int d0 = 0; d0 < 8; ++d0) qr[d0] = *reinterpret_cast<const bf16x8*>(Qw + d0 * 16);
    const int cq = 4 * qb + (wid >> 1), qi = 32 * (wid & 1) + r32;
    const int kc_lo = (4 * qb - 8) > 0 ? (4 * qb - 8) : 0, NT = 4 * qb + 4 - kc_lo;
    const int my_lo = (cq - 8) > 0 ? (cq - 8) : 0;
    const int sr = tid >> 4, sc = (tid & 15) * 8, vst0 = v_st(sr, sc), vst1 = v_st(32 + sr, sc);
    const int vb0 = (int)(uintptr_t)V_lds + v_rd_base(lane);
    const bf16* Kg = proj + ((size_t)b * SEQ + sr) * LDP + COL_K + h * 128 + sc;
    const bf16* Vg = proj + ((size_t)b * SEQ + sr) * LDP + COL_V + h * 128 + sc;
    bf16x8 sV0, sV1, sK0, sK1;
#define SLOAD(kc) do { const size_t ro = (size_t)(kc) * 64 * LDP; sV0 = *(const bf16x8*)(Vg + ro); sV1 = *(const bf16x8*)(Vg + ro + 32 * (size_t)LDP); sK0 = *(const bf16x8*)(Kg + ro); sK1 = *(const bf16x8*)(Kg + ro + 32 * (size_t)LDP); } while (0)
#define SWRITE(bufi) do { *(bf16x8*)(V_lds + (bufi) * SHM_V + vst0) = sV0; *(bf16x8*)(V_lds + (bufi) * SHM_V + vst1) = sV1; \
    *(bf16x8*)(K_lds + (bufi) * SHM_K + KSWZ(sr, sc * 2)) = sK0; *(bf16x8*)(K_lds + (bufi) * SHM_K + KSWZ(32 + sr, sc * 2)) = sK1; } while (0)
    SLOAD(kc_lo); SWRITE(0); SLOAD(kc_lo + 1);
    __syncthreads();
    for (int j = 0; j < NT; j += 2) {
        { const int kc = kc_lo + j; if (kc >= my_lo && kc <= cq) tile_compute(o, m_reg, l_reg, qr, K_lds, vb0, bt, al_l, cq - kc, qi, r32, hi); }
        SWRITE(1); if (j + 2 < NT) SLOAD(kc_lo + j + 2);
        __syncthreads();
        { const int kc = kc_lo + j + 1; if (kc >= my_lo && kc <= cq) tile_compute(o, m_reg, l_reg, qr, K_lds + SHM_K, vb0 + (int)SHM_V, bt, al_l, cq - kc, qi, r32, hi); }
        if (j + 2 < NT) { SWRITE(0); if (j + 3 < NT) SLOAD(kc_lo + j + 3); }
        __syncthreads();
    }
#undef SLOAD
#undef SWRITE
    if (hi == 0) li_l[r32] = l_reg; asm volatile("s_waitcnt lgkmcnt(0)" ::: "memory");
    bf16* Ow = yb + ((size_t)b * SEQ + (size_t)qb * 256 + wid * 32) * MIXW + h * 128 + r32;
#pragma unroll
    for (int r = 0; r < 16; ++r) { const int orow = crow(r, hi); const float rl = rcp(li_l[orow]);
#pragma unroll
        for (int d0 = 0; d0 < 4; ++d0) Ow[(size_t)orow * MIXW + d0 * 32] = f2bf16(o[d0][r] * rl); }
    asm volatile("s_waitcnt lgkmcnt(0)" ::: "memory");
}
#undef KSWZ
}

namespace s5 {
constexpr int XS_PITCH = 272;
constexpr int XS_WAVE = 32 * XS_PITCH;
constexpr int OFF_ECH = NWAVES * XS_WAVE;
constexpr int S5_LDS = OFF_ECH + 2 * 8 * 64 * 8;
struct cplx { float r, i; };
__device__ __forceinline__ cplx cmul(cplx a, cplx b) { return cplx{a.r * b.r - a.i * b.i, a.r * b.i + a.i * b.r}; }
__device__ __forceinline__ cplx cfma(cplx a, cplx x, cplx y) { return cplx{a.r * x.r - a.i * x.i + y.r, a.r * x.i + a.i * x.r + y.i}; }
__device__ __forceinline__ cplx csel(bool c, cplx a, cplx b) { return cplx{c ? a.r : b.r, c ? a.i : b.i}; }
__device__ __forceinline__ cplx cxor32(cplx a) { return cplx{__shfl_xor(a.r, 32), __shfl_xor(a.i, 32)}; }

__device__ __forceinline__ void chain(int b, int g, const bf16* __restrict__ proj, bf16* __restrict__ yc,
                                      const float* __restrict__ a_re, const float* __restrict__ a_im, const float* __restrict__ b_re, const float* __restrict__ b_im,
                                      const float* __restrict__ c_re, const float* __restrict__ c_im, const float* __restrict__ dvec, const float* __restrict__ log_step, char* lds) {
    int tid_ = threadIdx.x; asm volatile("" : "+v"(tid_));
    const int tid = tid_, wid = tid >> 6, lane = tid & 63, r32 = lane & 31, hi = lane >> 5, hcol = lane & 15, q4 = lane >> 4;
    const float step = expf(log_step[g]);
    cplx lam[2], l16[2], l64[2]; bf16x8 Bre[2], Bim[2];
#pragma unroll
    for (int pt = 0; pt < 2; ++pt) { const int p = 32 * pt + r32; const float are = a_re[g * 64 + p], aim = a_im[g * 64 + p];
        const float mag = expf(are * step), ang = aim * step; float sn, cs; sincosf(ang, &sn, &cs);
        const float lbr = mag * cs, lbi = mag * sn; lam[pt] = cplx{lbr, lbi};
        cplx t = cmul(lam[pt], lam[pt]); t = cmul(t, t); t = cmul(t, t); t = cmul(t, t); l16[pt] = t; t = cmul(t, t); t = cmul(t, t); l64[pt] = t;
        const float den = are * are + aim * aim, nr = lbr - 1.0f, cre = (nr * are + lbi * aim) / den, cim = (lbi * are - nr * aim) / den;
        const f32x4* br4 = (const f32x4*)(b_re + (size_t)(g * 64 + p) * 16 + 8 * hi); const f32x4* bi4 = (const f32x4*)(b_im + (size_t)(g * 64 + p) * 16 + 8 * hi);
        const f32x4 br0 = br4[0], br1 = br4[1], bi0 = bi4[0], bi1 = bi4[1];
        float vr[8], vi[8];
#pragma unroll
        for (int j = 0; j < 4; ++j) { vr[j] = cre * br0[j] - cim * bi0[j]; vi[j] = cre * bi0[j] + cim * br0[j]; vr[4 + j] = cre * br1[j] - cim * bi1[j]; vi[4 + j] = cre * bi1[j] + cim * br1[j]; }
        v4u wr_ = {cvtpk(vr[0], vr[1]), cvtpk(vr[2], vr[3]), cvtpk(vr[4], vr[5]), cvtpk(vr[6], vr[7])}; Bre[pt] = *reinterpret_cast<bf16x8*>(&wr_);
        v4u wi_ = {cvtpk(vi[0], vi[1]), cvtpk(vi[2], vi[3]), cvtpk(vi[4], vi[5]), cvtpk(vi[6], vi[7])}; Bim[pt] = *reinterpret_cast<bf16x8*>(&wi_); }
    bf16x8 cc[4];
#pragma unroll
    for (int ks = 0; ks < 4; ++ks) { const int p0 = 16 * ks + 4 * q4; const f32x4 cr = *(const f32x4*)(c_re + (size_t)(g * 16 + hcol) * 64 + p0), ci = *(const f32x4*)(c_im + (size_t)(g * 16 + hcol) * 64 + p0);
        v4u w = {cvtpk(cr[0], -ci[0]), cvtpk(cr[1], -ci[1]), cvtpk(cr[2], -ci[2]), cvtpk(cr[3], -ci[3])}; cc[ks] = *reinterpret_cast<bf16x8*>(&w); }
    const float dh = dvec[g * 16 + hcol];
    char* xs = lds + wid * XS_WAVE;
    const int tokA = 16 * ((r32 >> 2) & 1) + (r32 & 3) + 4 * (r32 >> 3);
    cplx Xr[2] = {cplx{0.f, 0.f}, cplx{0.f, 0.f}};
    for (int rd = 0; rd < 8; ++rd) {
        const int t0 = 64 * (8 * rd + wid);
        const size_t row0 = (size_t)b * SEQ + t0;
        bf16x8 A[2];
#pragma unroll
        for (int tt = 0; tt < 2; ++tt) A[tt] = *(const bf16x8*)(proj + (row0 + 32 * tt + tokA) * LDP + COL_U + 16 * g + 8 * hi);
        cplx E[2][2];
#pragma unroll
        for (int tt = 0; tt < 2; ++tt)
#pragma unroll
            for (int pt = 0; pt < 2; ++pt) {
                const f32x16 ur = __builtin_amdgcn_mfma_f32_32x32x16_bf16(A[tt], Bre[pt], f32x16{}, 0, 0, 0);
                const f32x16 ui = __builtin_amdgcn_mfma_f32_32x32x16_bf16(A[tt], Bim[pt], f32x16{}, 0, 0, 0);
                cplx e = cplx{0.f, 0.f};
#pragma unroll
                for (int r = 0; r < 16; ++r) e = cfma(lam[pt], e, cplx{ur[r], ui[r]});
                E[tt][pt] = e; }
        cplx Sg[4][2];
#pragma unroll
        for (int tt = 0; tt < 2; ++tt)
#pragma unroll
            for (int pt = 0; pt < 2; ++pt) { const cplx other = cxor32(E[tt][pt]); Sg[2 * tt][pt] = csel(hi == 0, E[tt][pt], other); Sg[2 * tt + 1][pt] = csel(hi == 0, other, E[tt][pt]); }
        LAS float* ech = (LAS float*)(lds + OFF_ECH) + (rd & 1) * (8 * 64 * 2);
#pragma unroll
        for (int pt = 0; pt < 2; ++pt) { cplx ec = Sg[0][pt]; ec = cfma(l16[pt], ec, Sg[1][pt]); ec = cfma(l16[pt], ec, Sg[2][pt]); ec = cfma(l16[pt], ec, Sg[3][pt]);
            if (hi == 0) { ech[(wid * 64 + 32 * pt + r32) * 2] = ec.r; ech[(wid * 64 + 32 * pt + r32) * 2 + 1] = ec.i; } }
        __syncthreads();
        cplx xin[2];
#pragma unroll
        for (int pt = 0; pt < 2; ++pt) { cplx x = Xr[pt]; xin[pt] = x;
#pragma unroll
            for (int w = 0; w < 8; ++w) { xin[pt] = csel(w == wid, x, xin[pt]); const cplx e = cplx{ech[(w * 64 + 32 * pt + r32) * 2], ech[(w * 64 + 32 * pt + r32) * 2 + 1]}; x = cfma(l64[pt], x, e); }
            Xr[pt] = x; }
#pragma unroll
        for (int tt = 0; tt < 2; ++tt) {
#pragma unroll
            for (int pt = 0; pt < 2; ++pt) {
                const cplx xb0 = xin[pt], xb1 = cfma(l16[pt], xb0, Sg[0][pt]), xb2 = cfma(l16[pt], xb1, Sg[1][pt]), xb3 = cfma(l16[pt], xb2, Sg[2][pt]);
                cplx x = (tt == 0) ? csel(hi == 0, xb0, xb1) : csel(hi == 0, xb2, xb3);
                bf16x8 a2 = A[tt]; asm volatile("" : "+v"(a2));
                const f32x16 ur = __builtin_amdgcn_mfma_f32_32x32x16_bf16(a2, Bre[pt], f32x16{}, 0, 0, 0);
                const f32x16 ui = __builtin_amdgcn_mfma_f32_32x32x16_bf16(a2, Bim[pt], f32x16{}, 0, 0, 0);
#pragma unroll
                for (int r = 0; r < 16; ++r) { x = cfma(lam[pt], x, cplx{ur[r], ui[r]});
                    *(LAS unsigned*)(xs + (16 * hi + r) * XS_PITCH + 4 * (32 * pt + r32)) = cvtpk(x.r, x.i); }
            }
            asm volatile("s_waitcnt lgkmcnt(0)" ::: "memory"); __builtin_amdgcn_wave_barrier();
#pragma unroll
            for (int mt = 0; mt < 2; ++mt) {
                f32x4 y4 = {0.f, 0.f, 0.f, 0.f}; asm volatile("" : "+v"(y4));
#pragma unroll
                for (int ks = 0; ks < 4; ++ks) { const bf16x8 a = *(const LAS bf16x8*)(xs + (16 * mt + hcol) * XS_PITCH + ks * 64 + q4 * 16);
                    y4 = __builtin_amdgcn_mfma_f32_16x16x32_bf16(a, cc[ks], y4, 0, 0, 0); }
#pragma unroll
                for (int r = 0; r < 4; ++r) { const size_t row = row0 + 32 * tt + 16 * mt + 4 * q4 + r;
                    const float uv = bf2f(proj[row * LDP + COL_U + 16 * g + hcol]);
                    const float yv = pg8::gelu_tanh(y4[r] + dh * uv), yn = __shfl_xor(yv, 1);
                    if (!(hcol & 1)) __hip_atomic_store((unsigned*)(yc + row * MIXW + 16 * g + hcol), cvtpk(yv, yn), __ATOMIC_RELAXED, __HIP_MEMORY_SCOPE_AGENT); }
            }
            asm volatile("s_waitcnt lgkmcnt(0)" ::: "memory"); __builtin_amdgcn_wave_barrier();
        }
    }
    __syncthreads();
}
}

namespace lru {
constexpr int XC_PITCH = 144;
constexpr int XC_WAVE = 64 * XC_PITCH;
constexpr int OFF_AG = NWAVES * XC_WAVE;
constexpr int LRU_LDS = OFF_AG + 2 * 32 * 16 * 8;
__device__ __forceinline__ void chain(int b, int n, int qd, const bf16* __restrict__ proj, bf16* __restrict__ ya,
                                      const float* __restrict__ conv_w, const float* __restrict__ conv_b, const float* __restrict__ wa, const float* __restrict__ ba,
                                      const float* __restrict__ wx, const float* __restrict__ bx, const float* __restrict__ lamp, char* lds) {
    int tid_ = threadIdx.x; asm volatile("" : "+v"(tid_));
    const int tid = tid_, wid = tid >> 6, lane = tid & 63, jc = lane & 15, q4 = lane >> 4;
    const int cho = 64 * n + 16 * qd + jc;
    const int chl = 64 * n + lane;
    const float spl = log1pf(expf(-lamp[cho])), c8l = -8.0f * spl * LOG2E;
    const float bao = ba[cho], bxo = bx[cho];
    const float wo0 = conv_w[0 * MIXW + cho], wo1 = conv_w[1 * MIXW + cho], wo2 = conv_w[2 * MIXW + cho], wo3 = conv_w[3 * MIXW + cho], cbo = conv_b[cho];
    const float wl0 = conv_w[0 * MIXW + chl], wl1 = conv_w[1 * MIXW + chl], wl2 = conv_w[2 * MIXW + chl], wl3 = conv_w[3 * MIXW + chl], cbl = conv_b[chl];
    bf16x8 Ba[2], Bx[2];
#pragma unroll
    for (int ks = 0; ks < 2; ++ks) { float va[8], vx[8];
#pragma unroll
        for (int j = 0; j < 8; ++j) { const size_t idx = ((size_t)n * 64 + 32 * ks + 8 * q4 + j) * 64 + 16 * qd + jc; va[j] = wa[idx]; vx[j] = wx[idx]; }
        v4u w0 = {cvtpk(va[0], va[1]), cvtpk(va[2], va[3]), cvtpk(va[4], va[5]), cvtpk(va[6], va[7])}; Ba[ks] = *reinterpret_cast<bf16x8*>(&w0);
        v4u w1 = {cvtpk(vx[0], vx[1]), cvtpk(vx[2], vx[3]), cvtpk(vx[4], vx[5]), cvtpk(vx[6], vx[7])}; Bx[ks] = *reinterpret_cast<bf16x8*>(&w1); }
    char* xcw = lds + wid * XC_WAVE;
    float Cr = 0.f;
    for (int rd = 0; rd < 8; ++rd) {
        const int t0 = 64 * (8 * rd + wid);
        const size_t row0 = (size_t)b * SEQ + t0;
        { const bf16* xp = proj + row0 * LDP + COL_LX + chl;
          float xm3 = 0.f, xm2 = 0.f, xm1 = 0.f;
          if (t0 > 0) { xm3 = bf2f(xp[-3 * (ptrdiff_t)LDP]); xm2 = bf2f(xp[-2 * (ptrdiff_t)LDP]); xm1 = bf2f(xp[-1 * (ptrdiff_t)LDP]); }
#pragma unroll 8
          for (int t = 0; t < 64; ++t) { const float x0 = bf2f(xp[(size_t)t * LDP]); const float xc = cbl + wl0 * xm3 + wl1 * xm2 + wl2 * xm1 + wl3 * x0;
              *(LAS bf16*)(xcw + t * XC_PITCH + 2 * lane) = f2bf16(xc); xm3 = xm2; xm2 = xm1; xm1 = x0; } }
        asm volatile("s_waitcnt lgkmcnt(0)" ::: "memory"); __builtin_amdgcn_wave_barrier();
        f32x4 ga[4], gx[4];
#pragma unroll
        for (int i = 0; i < 4; ++i) { const int tok = 16 * (jc >> 2) + 4 * i + (jc & 3);
            const bf16x8 a0 = *(const LAS bf16x8*)(xcw + tok * XC_PITCH + (0 + 8 * q4) * 2), a1 = *(const LAS bf16x8*)(xcw + tok * XC_PITCH + (32 + 8 * q4) * 2);
            f32x4 za = {0.f, 0.f, 0.f, 0.f}, zx = {0.f, 0.f, 0.f, 0.f}; asm volatile("" : "+v"(za), "+v"(zx));
            za = __builtin_amdgcn_mfma_f32_16x16x32_bf16(a0, Ba[0], za, 0, 0, 0); za = __builtin_amdgcn_mfma_f32_16x16x32_bf16(a1, Ba[1], za, 0, 0, 0);
            zx = __builtin_amdgcn_mfma_f32_16x16x32_bf16(a0, Bx[0], zx, 0, 0, 0); zx = __builtin_amdgcn_mfma_f32_16x16x32_bf16(a1, Bx[1], zx, 0, 0, 0);
            ga[i] = za; gx[i] = zx; }
        asm volatile("s_waitcnt lgkmcnt(0)" ::: "memory"); __builtin_amdgcn_wave_barrier();
        float hl[16], Pc[16];
        { const size_t rseg = row0 + 16 * q4; const bf16* xp = proj + rseg * LDP + COL_LX + cho;
          float xm3 = 0.f, xm2 = 0.f, xm1 = 0.f;
          if (t0 + 16 * q4 > 0) { xm3 = bf2f(xp[-3 * (ptrdiff_t)LDP]); xm2 = bf2f(xp[-2 * (ptrdiff_t)LDP]); xm1 = bf2f(xp[-1 * (ptrdiff_t)LDP]); }
          float h = 0.f, P = 1.f;
#pragma unroll
          for (int k = 0; k < 16; ++k) { const float x0 = bf2f(xp[(size_t)k * LDP]); const float xc = cbo + wo0 * xm3 + wo1 * xm2 + wo2 * xm1 + wo3 * x0; xm3 = xm2; xm2 = xm1; xm1 = x0;
              const float r = pg8::sigmoidf_(ga[k >> 2][k & 3] + bao), ig = pg8::sigmoidf_(gx[k >> 2][k & 3] + bxo);
              const float a = pg8::ex2(c8l * r); const float mult = sqrtf(fmaxf(1.0f - a * a, 0.f));
              h = a * h + mult * (ig * xc); P = a * P; hl[k] = h; Pc[k] = P; }
          LAS float* ag = (LAS float*)(lds + OFF_AG) + (rd & 1) * (32 * 16 * 2);
          ag[((4 * wid + q4) * 16 + jc) * 2] = P; ag[((4 * wid + q4) * 16 + jc) * 2 + 1] = h; }
        __syncthreads();
        float cin = 0.f;
        { const LAS float* ag = (const LAS float*)(lds + OFF_AG) + (rd & 1) * (32 * 16 * 2); const int myseg = 4 * wid + q4; float c = Cr;
#pragma unroll 8
          for (int s = 0; s < 32; ++s) { cin = (s == myseg) ? c : cin; c = ag[(s * 16 + jc) * 2] * c + ag[(s * 16 + jc) * 2 + 1]; }
          Cr = c; }
        { const size_t rseg = row0 + 16 * q4;
#pragma unroll
          for (int k = 0; k < 16; ++k) { const float h = hl[k] + Pc[k] * cin; const float gt = bf2f(proj[(rseg + k) * LDP + COL_LG + cho]);
              const float yv = h * gt, yn = __shfl_xor(yv, 1);
              if (!(jc & 1)) __hip_atomic_store((unsigned*)(ya + (rseg + k) * MIXW + cho), cvtpk(yv, yn), __ATOMIC_RELAXED, __HIP_MEMORY_SCOPE_AGENT); } }
    }
    __syncthreads();
}
}

#ifndef MK_N_LAUNCHES
#define MK_N_LAUNCHES 1
#endif
constexpr int N_PHASES = 1 + 8 * DEPTH;
constexpr bool ONE_LAUNCH = (MK_N_LAUNCHES == 1);
struct Args { const float* in[28]; float* out; unsigned char* ws; int ph_lo, ph_hi; };

__device__ __forceinline__ int opq_zero() { int z; asm volatile("s_mov_b32 %0, 0" : "=s"(z)); return z; }
__global__ void __launch_bounds__(NWAVES * 64, 2) fwd_kernel(Args args) {
    extern __shared__ __attribute__((aligned(16))) unsigned char lds[];
    const int tid = threadIdx.x;
    const int G = gridDim.x, bx = blockIdx.x;
    gu32* ctl = (gu32*)(args.ws + WS_CTL);
    for (int u = tid; u < (LDS_BYTES - LDSCTL_OFF) / 4; u += NWAVES * 64) ((LAS unsigned*)((LAS unsigned char*)lds + LDSCTL_OFF))[u] = 0u;
    __syncthreads();
    volatile LAS unsigned* MISC = (volatile LAS unsigned*)((LAS unsigned char*)lds + MISC_OFF);
    XcdBarrier bar; bar.bar = (unsigned*)(ctl + CW_BAR); bar.x = 0; bar.st = nullptr;
    if (ONE_LAUNCH) bar = xcd_barrier_post((unsigned*)(ctl + CW_BAR), MISC + 8);
    const int lo = args.ph_lo, hi = args.ph_hi;
#ifdef DBG_INV
    __builtin_amdgcn_fence(__ATOMIC_ACQUIRE, "agent"); asm volatile("s_waitcnt vmcnt(0)" ::: "memory"); __syncthreads();
#endif
#define IN(k) (lo <= (k) && (k) < hi)
#define SEAM(k) do { if (ONE_LAUNCH && IN(k) && IN((k) + 1)) xcd_barrier(bar); } while (0)

    const int NGW = G * NWAVES;
#define LANEW() int tl_ = threadIdx.x; asm volatile("" : "+v"(tl_)); const int lane = tl_ & 63, wave = __builtin_amdgcn_readfirstlane(tl_ >> 6), gw = bx * NWAVES + wave; (void)lane; (void)gw;
#define OPQ(p) ((p) + opq_zero())
#define PTRS() unsigned char* ws = OPQ(args.ws); float* X = OPQ(args.out); const float* x_in = OPQ(args.in[0]); \
    bf16* Hn = (bf16*)(ws + WS_H); bf16* PROJ = (bf16*)(ws + WS_PROJ); bf16* HID = (bf16*)(ws + WS_PROJ); \
    bf16* YA = (bf16*)(ws + WS_YA); bf16* YB = (bf16*)(ws + WS_YB); bf16* YC = (bf16*)(ws + WS_YC); bf16* PB = (bf16*)(ws + WS_PB); bf16* SB = (bf16*)(ws + WS_SB); \
    float* PAR = (float*)(ws + WS_PAR); const float* PL = PAR + (size_t)l * PAR_STRIDE; \
    (void)X; (void)x_in; (void)Hn; (void)PROJ; (void)HID; (void)YA; (void)YB; (void)YC; (void)PB; (void)SB; (void)PL;

#ifndef NO_PRO
    if (IN(0)) {
        const int l = 0; PTRS(); LANEW();
        LAS float* scr = (LAS float*)((LAS unsigned char*)lds + RING_OFF + wave * 16384);
        constexpr int I_IN = (DM / 64) * (INW / 32), I_BR = (MIXW / 64) * (DM / 32), I_OUT = (DM / 64) * (DM / 32), I_G = (DM / 64) * (FFH / 32), I_DN = (FFH / 64) * (DM / 32);
        constexpr int I_LAYER = I_IN + 4 * I_BR + I_OUT + 2 * I_G + I_DN;
        for (int it = gw; it < DEPTH * I_LAYER; it += NGW) {
            const int l = it / I_LAYER; int r = it % I_LAYER;
            if (r < I_IN) { transpose_item(args.in[2] + (size_t)l * DM * INW, DM, INW, (bf16*)(ws + WS_WIN) + (size_t)l * INW * DM, RowId{}, scr, r, lane); continue; } r -= I_IN;
            if (r < 3 * I_BR) { const int br = r / I_BR; const int dst = (br == 2) ? 3 : br;
                transpose_item(args.in[21] + ((size_t)l * 3 + br) * MIXW * DM, MIXW, DM, (bf16*)(ws + WS_WBR) + ((size_t)l * 4 + dst) * DM * MIXW, RowId{}, scr, r % I_BR, lane); continue; } r -= 3 * I_BR;
            if (r < I_BR) { transpose_item(args.in[20] + (size_t)l * MIXW * DM, MIXW, DM, (bf16*)(ws + WS_WBR) + ((size_t)l * 4 + 2) * DM * MIXW, RowId{}, scr, r, lane); continue; } r -= I_BR;
            if (r < I_OUT) { transpose_item(args.in[22] + (size_t)l * DM * DM, DM, DM, (bf16*)(ws + WS_WOUT) + (size_t)l * DM * DM, RowId{}, scr, r, lane); continue; } r -= I_OUT;
            if (r < I_G) { transpose_item(args.in[24] + (size_t)l * DM * FFH, DM, FFH, (bf16*)(ws + WS_WGU) + (size_t)l * 2 * FFH * DM, RowGU{0}, scr, r, lane); continue; } r -= I_G;
            if (r < I_G) { transpose_item(args.in[25] + (size_t)l * DM * FFH, DM, FFH, (bf16*)(ws + WS_WGU) + (size_t)l * 2 * FFH * DM, RowGU{1}, scr, r, lane); continue; } r -= I_G;
            transpose_item(args.in[26] + (size_t)l * FFH * DM, FFH, DM, (bf16*)(ws + WS_WDN) + (size_t)l * DM * FFH, RowId{}, scr, r, lane);
        }
        { const int gt = bx * (NWAVES * 64) + tl_, gs = G * (NWAVES * 64);
#define PCOPY(k, cnt, off) for (int i = gt; i < DEPTH * (cnt); i += gs) __hip_atomic_store(PAR + (size_t)(i / (cnt)) * PAR_STRIDE + (off) + (i % (cnt)), args.in[k][i], __ATOMIC_RELAXED, __HIP_MEMORY_SCOPE_AGENT)
          PCOPY(1, 2048, P_GMIX); PCOPY(3, 6144, P_GBIAS); PCOPY(4, 4096, P_CONVW); PCOPY(5, 1024, P_CONVB); PCOPY(7, 1024, P_BA); PCOPY(9, 1024, P_BX); PCOPY(10, 1024, P_LAM); PCOPY(11, 2056, P_RELB);
          PCOPY(12, 4096, P_ARE); PCOPY(13, 4096, P_AIM); PCOPY(18, 1024, P_D); PCOPY(19, 64, P_LOGSTEP); PCOPY(23, 2048, P_GFFN); PCOPY(6, 65536, P_WA); PCOPY(8, 65536, P_WX);
          PCOPY(14, 65536, P_BRE); PCOPY(15, 65536, P_BIM); PCOPY(16, 65536, P_CRE); PCOPY(17, 65536, P_CIM);
#undef PCOPY
          for (int i = gt; i < 2048; i += gs) __hip_atomic_store(PAR + P_GFIN + i, args.in[27][i], __ATOMIC_RELAXED, __HIP_MEMORY_SCOPE_AGENT); }
        for (int m = gw; m < M; m += NGW) rms_row_bf16(x_in + (size_t)m * DM, args.in[1], Hn + (size_t)m * DM, lane);
    }
#endif
    SEAM(0);

    for (int l = 0; l < DEPTH; ++l) {
        const int P = 1 + 8 * l;
#ifndef NO_G0
        if (IN(P + 0)) {
            PTRS();
            pg8::Gemm g{Hn, (const bf16*)(ws + WS_WIN) + (size_t)l * INW * DM, M, INW, DM}; pg8::StaticOrder S; S.init(M, INW, G, bx);
            pg8::EpiIn E{PROJ, PL + P_GBIAS};
            pg8::gemm_phase<pg8::EpiIn, pg8::StaticOrder, true, true>((LAS unsigned char*)lds + RING_OFF, g, S, E);
        }
#endif
        SEAM(P + 0);
        if (IN(P + 1)) {
            PTRS();
#if defined(NO_ATT) || defined(NO_S5) || defined(NO_LRU)
            { LANEW(); v4u z = {0u, 0u, 0u, 0u};
              for (size_t i = (size_t)bx * 512 + tl_; i < (size_t)M * MIXW / 8; i += (size_t)G * 512) {
#ifdef NO_ATT
                  ((v4u*)YB)[i] = z;
#endif
#ifdef NO_S5
                  ((v4u*)YC)[i] = z;
#endif
#ifdef NO_LRU
                  ((v4u*)YA)[i] = z;
#endif
              } }
#endif
#ifndef NO_ATT
            for (int i = bx; i < 512; i += G) {
                const int j = i & 255, bh = j >> 3, qb = (i < 256) ? 15 - (j & 7) : (j & 7);
                att::attn_unit(bh >> 3, bh & 7, qb, PROJ, YB, PL + P_RELB + (bh & 7) * 257, (char*)lds + RING_OFF);
            }
#endif
            __syncthreads();
#ifndef NO_S5
            for (int i = bx; i < 256; i += G)
                s5::chain(i >> 6, i & 63, PROJ, YC, PL + P_ARE, PL + P_AIM, PL + P_BRE, PL + P_BIM,
                          PL + P_CRE, PL + P_CIM, PL + P_D, PL + P_LOGSTEP, (char*)lds + RING_OFF);
#endif
#ifndef NO_LRU
            for (int i = bx; i < 256; i += G)
                lru::chain(i >> 6, (i >> 2) & 15, i & 3, PROJ, YA, PL + P_CONVW, PL + P_CONVB, PL + P_WA, PL + P_BA,
                           PL + P_WX, PL + P_BX, PL + P_LAM, (char*)lds + RING_OFF);
#endif
        }
        SEAM(P + 1);
#ifndef NO_G2
        if (IN(P + 2)) {
            PTRS();
            const bf16* WB = (const bf16*)(ws + WS_WBR) + (size_t)l * 4 * DM * MIXW;
            pg8::StaticOrder S; S.init(M, DM, G, bx);
            { pg8::Gemm g{YA, WB + 0 * (size_t)DM * MIXW, M, DM, MIXW}; pg8::EpiBr<0> E{PROJ, PB, SB}; pg8::gemm_phase<pg8::EpiBr<0>, pg8::StaticOrder, true, true>((LAS unsigned char*)lds + RING_OFF, g, S, E); }
            { pg8::Gemm g{YB, WB + 1 * (size_t)DM * MIXW, M, DM, MIXW}; pg8::EpiBr<1> E{PROJ, PB, SB}; pg8::gemm_phase<pg8::EpiBr<1>, pg8::StaticOrder, true, true>((LAS unsigned char*)lds + RING_OFF, g, S, E); }
            { pg8::Gemm g{YC, WB + 2 * (size_t)DM * MIXW, M, DM, MIXW}; pg8::EpiBr<2> E{PROJ, PB, SB}; pg8::gemm_phase<pg8::EpiBr<2>, pg8::StaticOrder, true, true>((LAS unsigned char*)lds + RING_OFF, g, S, E); }
            { pg8::Gemm g{YC, WB + 3 * (size_t)DM * MIXW, M, DM, MIXW}; pg8::EpiBr<3> E{PROJ, PB, SB}; pg8::gemm_phase<pg8::EpiBr<3>, pg8::StaticOrder, true, true>((LAS unsigned char*)lds + RING_OFF, g, S, E); }
        }
#endif
        SEAM(P + 2);
#ifndef NO_G3
        if (IN(P + 3)) {
            PTRS();
            pg8::Gemm g{PB, (const bf16*)(ws + WS_WOUT) + (size_t)l * DM * DM, M, DM, DM}; pg8::StaticOrder S; S.init(M, DM, G, bx);
            pg8::EpiRes E{l == 0 ? x_in : (const float*)X, X};
            pg8::gemm_phase<pg8::EpiRes, pg8::StaticOrder, true, true>((LAS unsigned char*)lds + RING_OFF, g, S, E);
        }
#endif
        SEAM(P + 3);
        if (IN(P + 4)) { PTRS(); LANEW(); for (int m = gw; m < M; m += NGW) rms_row_bf16(X + (size_t)m * DM, PL + P_GFFN, Hn + (size_t)m * DM, lane); }
        SEAM(P + 4);
#ifndef NO_G5
        if (IN(P + 5)) {
            PTRS();
            pg8::Gemm g{Hn, (const bf16*)(ws + WS_WGU) + (size_t)l * 2 * FFH * DM, M, 2 * FFH, DM}; pg8::StaticOrder S; S.init(M, 2 * FFH, G, bx);
            pg8::EpiSwiglu E{HID};
            pg8::gemm_phase<pg8::EpiSwiglu, pg8::StaticOrder, true, true>((LAS unsigned char*)lds + RING_OFF, g, S, E);
        }
#endif
        SEAM(P + 5);
#ifndef NO_G6
        if (IN(P + 6)) {
            PTRS();
            pg8::Gemm g{HID, (const bf16*)(ws + WS_WDN) + (size_t)l * DM * FFH, M, DM, FFH}; pg8::StaticOrder S; S.init(M, DM, G, bx);
            pg8::EpiRes E{X, X};
            pg8::gemm_phase<pg8::EpiRes, pg8::StaticOrder, true, true>((LAS unsigned char*)lds + RING_OFF, g, S, E);
        }
#endif
        SEAM(P + 6);
        if (IN(P + 7)) {
            PTRS(); LANEW();
            if (l + 1 < DEPTH) { for (int m = gw; m < M; m += NGW) rms_row_bf16(X + (size_t)m * DM, PL + PAR_STRIDE + P_GMIX, Hn + (size_t)m * DM, lane); }
            else { for (int m = gw; m < M; m += NGW) rms_row_f32(X + (size_t)m * DM, PAR + P_GFIN, lane); }
        }
        if (l + 1 < DEPTH) SEAM(P + 7);
    }
#undef IN
#undef SEAM
}

#ifdef DBG_DUMP
__global__ void dbg_dump(const bf16* src, float* out) {
    for (size_t i = (size_t)blockIdx.x * 256 + threadIdx.x; i < (size_t)M * DM; i += (size_t)gridDim.x * 256) { const size_t m = i / DM, c = i % DM; out[i] = bf2f(src[m * DBG_PITCH + (c % DBG_PITCH)]); }
}
#endif
extern "C" void kernel_launch(void* const* d_in, const int* in_sizes, int n_in, void* d_out, int out_size, void* d_ws, size_t ws_size, hipStream_t stream) {
    static int grid = 0;
    if (grid == 0) {
        if (n_in != 28 || in_sizes[0] != M * DM || out_size != M * DM || ws_size < WS_END) {
            fprintf(stderr, "kernel_launch: built for 28 inputs, x/out of %d floats, >= %zu bytes of workspace; got n_in %d, in0 %d, out %d, ws %zu; nothing launched\n", M * DM, (size_t)WS_END, n_in, n_in > 0 ? in_sizes[0] : -1, out_size, ws_size);
            grid = -1; return; }
        int dev = 0, cus = 0, per_cu = 0;
        if (hipGetDevice(&dev) != hipSuccess || hipDeviceGetAttribute(&cus, hipDeviceAttributeMultiprocessorCount, dev) != hipSuccess) { fprintf(stderr, "kernel_launch: device query failed\n"); grid = -1; return; }
        if (hipFuncSetAttribute((const void*)fwd_kernel, hipFuncAttributeMaxDynamicSharedMemorySize, LDS_BYTES) != hipSuccess) { fprintf(stderr, "kernel_launch: hipFuncSetAttribute failed\n"); grid = -1; return; }
        if (hipOccupancyMaxActiveBlocksPerMultiprocessor(&per_cu, (const void*)fwd_kernel, NWAVES * 64, LDS_BYTES) != hipSuccess || per_cu < 1)
            fprintf(stderr, "kernel_launch: note: occupancy query reports %d workgroups per CU\n", per_cu);
        (void)hipGetLastError();
        grid = cus;
        if (grid > 256) grid = 256;
    }
    if (grid < 0) return;
    if (hipMemsetAsync((char*)d_ws + WS_CTL, 0, CTL_ZERO_BYTES, stream) != hipSuccess) { fprintf(stderr, "kernel_launch: memset failed\n"); return; }
    Args a{};
    for (int i = 0; i < 28; ++i) a.in[i] = (const float*)d_in[i];
    a.out = (float*)d_out; a.ws = (unsigned char*)d_ws;
    if (ONE_LAUNCH) {
        a.ph_lo = 0; a.ph_hi = N_PHASES;
        hipLaunchKernelGGL(fwd_kernel, dim3(grid), dim3(NWAVES * 64), LDS_BYTES, stream, a);
    } else {
#ifdef DBG_STOP
        for (int p = 0; p < DBG_STOP; ++p) { a.ph_lo = p;
#else
        for (int p = 0; p < N_PHASES; ++p) { a.ph_lo = p;
#endif
         a.ph_hi = p + 1; hipLaunchKernelGGL(fwd_kernel, dim3(grid), dim3(NWAVES * 64), LDS_BYTES, stream, a); }
#ifdef DBG_DUMP
        hipLaunchKernelGGL(dbg_dump, dim3(1024), dim3(256), 0, stream, (const bf16*)((unsigned char*)d_ws + DBG_DUMP), (float*)d_out);
#endif
    }
    const hipError_t le = hipPeekAtLastError();
    if (le != hipSuccess) fprintf(stderr, "kernel_launch: launch failed: %s\n", hipGetErrorName(le));
}
```

```cpp
#include <hip/hip_runtime.h>
#include <cstdio>
#include <cstdint>
namespace pg8 {
#define PG8_LAS __attribute__((address_space(3)))
typedef unsigned short bf16_t;
typedef short bf16x8 __attribute__((ext_vector_type(8)));
typedef float f32x4 __attribute__((ext_vector_type(4)));
typedef unsigned u32x4 __attribute__((ext_vector_type(4)));
typedef unsigned u32x2 __attribute__((ext_vector_type(2)));
constexpr int BM = 256, BK = 64, HALF = 128, HTB = HALF * BK * 2  , STAGE_BYTES = 8 * HTB, NXCD = 8, WGM = 8;

__host__ __device__ __forceinline__ int lds_byte(int r, int c) { const int st = (r >> 4) * 2 + (c >> 5), rr = r & 15, cc = c & 31, ob = rr * 64 + cc * 2; return st * 1024 + (ob ^ (((ob >> 9) & 1) << 5)); }
__host__ __device__ __forceinline__ void stage_rc(int b, int& R, int& C) { const int st = b / 1024, sb = b % 1024, swz = sb ^ (((sb >> 9) & 1) << 5); R = (st >> 1) * 16 + swz / 64; C = (st & 1) * 32 + (swz % 64) / 2; }
__host__ __device__ __forceinline__ int perm32(int rho) { const int n = rho >> 4, i = rho & 15; return 8 * (i >> 2) + 4 * n + (i & 3); }

struct Unit { int pm, pn; };
struct Gemm { const bf16_t* A; const bf16_t* Bt; int M, N, K; };

struct StaticOrder {
    int nM, nN, nwg, G, c;
    __host__ __device__ void init(int M, int N, int G_, int c_) { nM = M / BM; nN = N / BM; nwg = nM * nN; G = G_; c = c_; }
    __host__ __device__ bool next(int i, Unit& u) const {
        const long L = (long)i * G + c; if (L >= nwg) return false;
        int wgid = (int)L; { const int q = nwg / NXCD, r = nwg % NXCD, xcd = wgid % NXCD, off = wgid / NXCD; wgid = (xcd < r ? xcd * (q + 1) : r * (q + 1) + (xcd - r) * q) + off; }
        const int nig = WGM * nN, gid = wgid / nig, fm = gid * WGM, gsz = (nM - fm) < WGM ? (nM - fm) : WGM;
        u.pm = fm + ((wgid % nig) % gsz); u.pn = (wgid % nig) / gsz; return true;
    }
    __device__ __forceinline__ void a_ready(const Unit&) const {}
    __device__ __forceinline__ void done(const Unit&) const {}
};

__device__ __forceinline__ unsigned cvt_pk_bf16(float lo, float hi) { typedef __bf16 bf2_ __attribute__((ext_vector_type(2))); typedef float f2_ __attribute__((ext_vector_type(2))); const f2_ v_ = {lo, hi}; const bf2_ r_ = __builtin_convertvector(v_, bf2_); return __builtin_bit_cast(unsigned, r_); }
__device__ __forceinline__ float ex2(float x) { return __builtin_amdgcn_exp2f(x); }
__device__ __forceinline__ float rcp(float x) { return __builtin_amdgcn_rcpf(x); }
__device__ __forceinline__ float sigmoidf_(float x) { return rcp(1.0f + ex2(-1.4426950408889634f * x)); }
__device__ __forceinline__ float gelu_tanh(float x) { const float u = x * (1.0f + 0.044715f * x * x); return x * rcp(1.0f + ex2(-2.302208198f * u)); }
__device__ __forceinline__ float silu_(float x) { return x * sigmoidf_(x); }
__device__ __forceinline__ float bf_lo(unsigned w) { return __uint_as_float(w << 16); }
__device__ __forceinline__ float bf_hi(unsigned w) { return __uint_as_float(w & 0xffff0000u); }

constexpr int LDP = 12288 + 64;
constexpr int GATE_COL = 6144;
constexpr float QSCALE = 0.12751743082459868f;

struct EpiIn {
    static constexpr bool PERM = true, AFTER_DRAIN = false, IDEMPOTENT = true;
    bf16_t* O; const float* gbias; const PG8_LAS float* rinv;
    template <int MODE> __device__ __forceinline__ void run(const f32x4 (&acc)[2][2][4][2], const Unit& u, int wr, int wc, int fr, int fq) const {
        const int row0 = u.pm * BM + wr * 64 + fr, col0 = u.pn * BM + wc * 32 + 8 * fq;
        f32x4 bv[2][2];
#pragma unroll
        for (int bj = 0; bj < 2; ++bj)
#pragma unroll
            for (int n = 0; n < 2; ++n) bv[bj][n] = (MODE == 3) ? *(const f32x4*)(gbias + (col0 - GATE_COL) + bj * HALF + 4 * n) : (f32x4){0.f, 0.f, 0.f, 0.f};
#pragma unroll
        for (int ai = 0; ai < 2; ++ai)
#pragma unroll
            for (int m = 0; m < 4; ++m) { bf16_t* rowp = O + (size_t)(row0 + ai * HALF + m * 16) * LDP + col0; const float rs = rinv[wr * 64 + fr + ai * HALF + m * 16];
#pragma unroll
                for (int bj = 0; bj < 2; ++bj) { f32x4 v0 = acc[ai][bj][m][0] * rs, v1 = acc[ai][bj][m][1] * rs;
                    if (MODE == 1) {
#pragma unroll
                        for (int j = 0; j < 4; ++j) { v0[j] = gelu_tanh(v0[j]); v1[j] = gelu_tanh(v1[j]); }
                    } else if (MODE == 2) { v0 = v0 * QSCALE; v1 = v1 * QSCALE; }
                    else if (MODE == 3) { v0 = v0 + bv[bj][0]; v1 = v1 + bv[bj][1];
#pragma unroll
                        for (int j = 0; j < 4; ++j) { v0[j] = sigmoidf_(v0[j]); v1[j] = sigmoidf_(v1[j]); } }
                    u32x4 w; w.x = cvt_pk_bf16(v0[0], v0[1]); w.y = cvt_pk_bf16(v0[2], v0[3]); w.z = cvt_pk_bf16(v1[0], v1[1]); w.w = cvt_pk_bf16(v1[2], v1[3]);
                    *(u32x4*)(rowp + bj * HALF) = w; } }
    }
    __device__ __forceinline__ void operator()(const f32x4 (&acc)[2][2][4][2], const Unit& u, int wr, int wc, int fr, int fq) const {
        const int pn = u.pn;
        if (pn >= 24) run<3>(acc, u, wr, wc, fr, fq);
        else if (pn < 4 || pn >= 12) run<0>(acc, u, wr, wc, fr, fq);
        else if (pn < 8) run<1>(acc, u, wr, wc, fr, fq);
        else run<2>(acc, u, wr, wc, fr, fq);
    }
};

struct EpiNull {
    static constexpr bool PERM = true, AFTER_DRAIN = false, IDEMPOTENT = false;
    __device__ __forceinline__ void operator()(const f32x4 (&acc)[2][2][4][2], const Unit&, int, int, int, int) const {
#pragma unroll
        for (int ai = 0; ai < 2; ++ai)
#pragma unroll
            for (int bj = 0; bj < 2; ++bj)
#pragma unroll
                for (int m = 0; m < 4; ++m) { f32x4 a = acc[ai][bj][m][0], b = acc[ai][bj][m][1]; asm volatile("" :: "v"(a), "v"(b)); }
    }
};

struct EpiGlu {
    static constexpr bool PERM = true, AFTER_DRAIN = false, IDEMPOTENT = true;
    const bf16_t* G; bf16_t* PB;
    __device__ __forceinline__ void operator()(const f32x4 (&acc)[2][2][4][2], const Unit& u, int wr, int wc, int fr, int fq) const {
        const int row0 = u.pm * BM + wr * 64 + fr, col0 = u.pn * HALF + wc * 32 + 8 * fq;
        u32x4 gw[2][4];
#pragma unroll
        for (int ai = 0; ai < 2; ++ai)
#pragma unroll
            for (int m = 0; m < 4; ++m) gw[ai][m] = *(const u32x4*)(G + (size_t)(row0 + ai * HALF + m * 16) * LDP + GATE_COL + 4096 + col0);
#pragma unroll
        for (int ai = 0; ai < 2; ++ai)
#pragma unroll
            for (int m = 0; m < 4; ++m) { float o[8];
#pragma unroll
                for (int j = 0; j < 4; ++j) {
                    o[2 * j] = bf_lo(gw[ai][m][j]) * (acc[ai][0][m][j >> 1][2 * (j & 1)] * sigmoidf_(acc[ai][1][m][j >> 1][2 * (j & 1)]));
                    o[2 * j + 1] = bf_hi(gw[ai][m][j]) * (acc[ai][0][m][j >> 1][2 * (j & 1) + 1] * sigmoidf_(acc[ai][1][m][j >> 1][2 * (j & 1) + 1])); }
                u32x4 w; w.x = cvt_pk_bf16(o[0], o[1]); w.y = cvt_pk_bf16(o[2], o[3]); w.z = cvt_pk_bf16(o[4], o[5]); w.w = cvt_pk_bf16(o[6], o[7]);
                *(u32x4*)(PB + (size_t)(row0 + ai * HALF + m * 16) * 2048 + col0) = w; }
    }
};
struct EpiBrAcc {
    static constexpr bool PERM = true, AFTER_DRAIN = false, IDEMPOTENT = false;
    const bf16_t* G; bf16_t* PB; int gi;
    __device__ __forceinline__ void operator()(const f32x4 (&acc)[2][2][4][2], const Unit& u, int wr, int wc, int fr, int fq) const {
        const int row0 = u.pm * BM + wr * 64 + fr, col0 = u.pn * BM + wc * 32 + 8 * fq;
#pragma unroll
        for (int ai = 0; ai < 2; ++ai)
#pragma unroll
            for (int hb = 0; hb < 2; ++hb) {
                u32x4 gw[2][2], pw[2][2];
#pragma unroll
                for (int mi = 0; mi < 2; ++mi)
#pragma unroll
                    for (int bj = 0; bj < 2; ++bj) { const size_t row = (size_t)(row0 + ai * HALF + (hb * 2 + mi) * 16); const int col = col0 + bj * HALF;
                        gw[mi][bj] = *(const u32x4*)(G + row * LDP + GATE_COL + 2048 * gi + col);
                        pw[mi][bj] = *(const u32x4*)(PB + row * 2048 + col); }
#pragma unroll
                for (int mi = 0; mi < 2; ++mi)
#pragma unroll
                    for (int bj = 0; bj < 2; ++bj) { const int m = hb * 2 + mi; const size_t row = (size_t)(row0 + ai * HALF + m * 16); const int col = col0 + bj * HALF;
                        float o[8];
#pragma unroll
                        for (int j = 0; j < 4; ++j) {
                            o[2 * j] = bf_lo(pw[mi][bj][j]) + bf_lo(gw[mi][bj][j]) * acc[ai][bj][m][j >> 1][2 * (j & 1)];
                            o[2 * j + 1] = bf_hi(pw[mi][bj][j]) + bf_hi(gw[mi][bj][j]) * acc[ai][bj][m][j >> 1][2 * (j & 1) + 1]; }
                        u32x4 w; w.x = cvt_pk_bf16(o[0], o[1]); w.y = cvt_pk_bf16(o[2], o[3]); w.z = cvt_pk_bf16(o[4], o[5]); w.w = cvt_pk_bf16(o[6], o[7]);
                        *(u32x4*)(PB + row * 2048 + col) = w; }
            }
    }
};

struct EpiRes {
    static constexpr bool PERM = false, AFTER_DRAIN = false, IDEMPOTENT = false;
    const float* base; float* out; bf16_t* hx; float* part;
    __device__ __forceinline__ void operator()(const f32x4 (&acc)[2][2][4][2], const Unit& u, int wr, int wc, int fr, int fq) const {
        const int row0 = u.pm * BM + wr * 64 + fr, col0 = u.pn * BM + wc * 32 + 4 * fq;
#pragma unroll
        for (int ai = 0; ai < 2; ++ai) {
            f32x4 bs[4][2][2];
#pragma unroll
            for (int m = 0; m < 4; ++m) { const size_t off = (size_t)(row0 + ai * HALF + m * 16) * 2048 + col0;
#pragma unroll
                for (int bj = 0; bj < 2; ++bj)
#pragma unroll
                    for (int n = 0; n < 2; ++n) bs[m][bj][n] = *(const f32x4*)(base + off + bj * HALF + n * 16); }
#pragma unroll
            for (int m = 0; m < 4; ++m) { const size_t off = (size_t)(row0 + ai * HALF + m * 16) * 2048 + col0; float ss = 0.f;
#pragma unroll
                for (int bj = 0; bj < 2; ++bj) { const f32x4 v0 = bs[m][bj][0] + acc[ai][bj][m][0], v1 = bs[m][bj][1] + acc[ai][bj][m][1];
                    *(f32x4*)(out + off + bj * HALF) = v0; *(f32x4*)(out + off + bj * HALF + 16) = v1;
                    ss += ((v0[0] * v0[0] + v0[1] * v0[1]) + (v0[2] * v0[2] + v0[3] * v0[3])) + ((v1[0] * v1[0] + v1[1] * v1[1]) + (v1[2] * v1[2] + v1[3] * v1[3]));
                    const unsigned a0 = cvt_pk_bf16(v0[0], v0[1]), a1 = cvt_pk_bf16(v0[2], v0[3]), b0 = cvt_pk_bf16(v1[0], v1[1]), b1 = cvt_pk_bf16(v1[2], v1[3]);
                    const auto s0 = __builtin_amdgcn_permlane16_swap(a0, b0, false, false); const auto s1 = __builtin_amdgcn_permlane16_swap(a1, b1, false, false);
                    u32x4 w = {s0[0], s1[0], s0[1], s1[1]};
                    *(u32x4*)(hx + off + bj * HALF + ((fq & 1) ? 12 : 0)) = w; }
                { const unsigned sb_ = __builtin_bit_cast(unsigned, ss); const auto t16 = __builtin_amdgcn_permlane16_swap(sb_, sb_, false, false);
                  ss = __builtin_bit_cast(float, (unsigned)t16[0]) + __builtin_bit_cast(float, (unsigned)t16[1]);
                  const unsigned sc_ = __builtin_bit_cast(unsigned, ss); const auto t32 = __builtin_amdgcn_permlane32_swap(sc_, sc_, false, false);
                  ss = __builtin_bit_cast(float, (unsigned)t32[0]) + __builtin_bit_cast(float, (unsigned)t32[1]); }
                part[((size_t)u.pn * 16384 + (row0 + ai * HALF + m * 16)) * 4 + wc] = ss; }
        }
    }
};

struct EpiSwiglu {
    static constexpr bool PERM = true, AFTER_DRAIN = false, IDEMPOTENT = false;
    bf16_t* Hd; const PG8_LAS float* rinv;
    __device__ __forceinline__ void operator()(const f32x4 (&acc)[2][2][4][2], const Unit& u, int wr, int wc, int fr, int fq) const {
        const int row0 = u.pm * BM + wr * 64 + fr, col0 = u.pn * HALF + wc * 32 + 8 * fq;
#pragma unroll
        for (int ai = 0; ai < 2; ++ai)
#pragma unroll
            for (int m = 0; m < 4; ++m) { bf16_t* rowp = Hd + (size_t)(row0 + ai * HALF + m * 16) * 5632 + col0;
                float o[8]; const float rs = rinv[wr * 64 + fr + ai * HALF + m * 16];
#pragma unroll
                for (int j = 0; j < 4; ++j) { o[j] = silu_(acc[ai][0][m][0][j] * rs) * (acc[ai][1][m][0][j] * rs); o[4 + j] = silu_(acc[ai][0][m][1][j] * rs) * (acc[ai][1][m][1][j] * rs); }
                u32x4 w; w.x = cvt_pk_bf16(o[0], o[1]); w.y = cvt_pk_bf16(o[2], o[3]); w.z = cvt_pk_bf16(o[4], o[5]); w.w = cvt_pk_bf16(o[6], o[7]);
                *(u32x4*)rowp = w; }
    }
};

template <class Epi, class Sched, bool ALIGN_EPI = false, bool SP2 = false>
__device__ __forceinline__ void gemm_phase(PG8_LAS unsigned char* lds, const Gemm g, const Sched& S, const Epi& E) {
    int tid_ = threadIdx.x; asm volatile("" : "+v"(tid_));
    const int tid = tid_, wid = __builtin_amdgcn_readfirstlane(tid >> 6), lane = tid & 63, wr = wid >> 2, wc = wid & 3, fr = lane & 15, fq = lane >> 4;
    const int K = g.K, nt = K / BK;
    unsigned voffA[2], voffB[2];
#pragma unroll
    for (int i = 0; i < 2; ++i) { int R, C; stage_rc(tid * 16 + i * 8192, R, C); const int Rb = Epi::PERM ? ((R & ~31) + perm32(R & 31)) : R;
        voffA[i] = (unsigned)(R * K + C) * 2u; voffB[i] = (unsigned)(Rb * K + C) * 2u; }
    const size_t kstep = (size_t)(BK * 2);
    const size_t hstep = (size_t)HALF * K * 2;
    const size_t tstep = 2 * hstep;
    const unsigned ldsw = (unsigned)wid * 1024u;
    const int aoff = lds_byte(wr * 64 + fr, fq * 8), boff = lds_byte(wc * 32 + fr, fq * 8);
#define PG8_SA(b, h) (((b) * 2 + (h)) * HTB)
#define PG8_SB(b, h) ((4 + (b) * 2 + (h)) * HTB)
#define PG8_STAGE(bufoff, gbase, voff) do { _Pragma("unroll") for (int _i = 0; _i < 2; ++_i) \
        __builtin_amdgcn_global_load_lds((const unsigned*)((const char*)(gbase) + (voff)[_i]), (PG8_LAS unsigned*)(lds + (bufoff) + ldsw + _i * 8192), 16, 0, 0); } while (0)
#define PG8_LDA(dst, b, h) do { _Pragma("unroll") for (int m = 0; m < 4; ++m) _Pragma("unroll") for (int k = 0; k < 2; ++k) dst[m][k] = *(const PG8_LAS bf16x8*)(lds + PG8_SA(b, h) + aoff + m * 2048 + k * 1024); } while (0)
#define PG8_LDB(dst, b, h) do { _Pragma("unroll") for (int n = 0; n < 2; ++n) _Pragma("unroll") for (int k = 0; k < 2; ++k) dst[n][k] = *(const PG8_LAS bf16x8*)(lds + PG8_SB(b, h) + boff + n * 2048 + k * 1024); } while (0)
#define PG8_MMA(ai, bj, At, Bt) do { __builtin_amdgcn_s_setprio(1); _Pragma("unroll") for (int m = 0; m < 4; ++m) _Pragma("unroll") for (int n = 0; n < 2; ++n) _Pragma("unroll") for (int k = 0; k < 2; ++k) \
        acc[ai][bj][m][n] = __builtin_amdgcn_mfma_f32_16x16x32_bf16(Bt[n][k], At[m][k], acc[ai][bj][m][n], 0, 0, 0); __builtin_amdgcn_s_setprio(0); } while (0)
#define PG8_WAIT_V(n) asm volatile("s_waitcnt vmcnt(" #n ")" ::: "memory")
#define PG8_WAIT_L(n) asm volatile("s_waitcnt lgkmcnt(" #n ")" ::: "memory")
#define PG8_BAR __builtin_amdgcn_s_barrier()
#define PG8_SCHED __builtin_amdgcn_sched_barrier(0)
    Unit cur, nxt; int ui = 0;
    if (!S.next(0, cur)) return;
    f32x4 acc[2][2][4][2];
#pragma unroll
    for (int a = 0; a < 2; ++a)
#pragma unroll
        for (int b = 0; b < 2; ++b)
#pragma unroll
            for (int m = 0; m < 4; ++m)
#pragma unroll
                for (int n = 0; n < 2; ++n) acc[a][b][m][n] = (f32x4){0.f, 0.f, 0.f, 0.f};
    bf16x8 At[4][2], B0[2][2], B1[2][2];
    const char* cA = (const char*)g.A + (size_t)cur.pm * tstep; const char* cB = (const char*)g.Bt + (size_t)cur.pn * tstep;
    S.a_ready(cur);
    if constexpr (SP2) {
        PG8_STAGE(PG8_SB(0, 0), cB, voffB); PG8_STAGE(PG8_SB(0, 1), cB + hstep, voffB); PG8_STAGE(PG8_SA(0, 0), cA, voffA); PG8_STAGE(PG8_SA(0, 1), cA + hstep, voffA);
        if (wr == 1) PG8_BAR;
        PG8_WAIT_V(2); PG8_BAR;
        PG8_STAGE(PG8_SB(1, 0), cB + kstep, voffB); PG8_STAGE(PG8_SA(1, 0), cA + kstep, voffA); PG8_STAGE(PG8_SB(1, 1), cB + hstep + kstep, voffB);
        PG8_WAIT_V(6); PG8_BAR;
    } else {
        PG8_STAGE(PG8_SB(0, 0), cB, voffB); PG8_STAGE(PG8_SA(0, 0), cA, voffA); PG8_STAGE(PG8_SB(0, 1), cB + hstep, voffB); PG8_STAGE(PG8_SA(0, 1), cA + hstep, voffA);
        if (wr == 1) PG8_BAR;
        PG8_WAIT_V(4); PG8_BAR;
        PG8_STAGE(PG8_SB(1, 0), cB + kstep, voffB); PG8_STAGE(PG8_SA(1, 0), cA + kstep, voffA); PG8_STAGE(PG8_SB(1, 1), cB + hstep + kstep, voffB);
        PG8_WAIT_V(6); PG8_BAR;
    }
    for (;;) {
        const bool has_next = S.next(ui + 1, nxt);
        const char* nA = has_next ? (const char*)g.A + (size_t)nxt.pm * tstep : cA; const char* nB = has_next ? (const char*)g.Bt + (size_t)nxt.pn * tstep : cB;
        for (int t = 0; t < nt; t += 2) {
            const bool last = (t == nt - 2);
            const char* a1 = cA + (size_t)(t + 1) * kstep;
            const char* a2 = last ? nA : cA + (size_t)(t + 2) * kstep; const char* b2 = last ? nB : cB + (size_t)(t + 2) * kstep;
            const char* a3 = a2 + kstep; const char* b3 = b2 + kstep;
            if (last && has_next) S.a_ready(nxt);
            if constexpr (SP2) {
            PG8_LDB(B0, 0, 0); PG8_LDB(B1, 0, 1); PG8_SCHED; PG8_LDA(At, 0, 0); PG8_STAGE(PG8_SA(1, 1), a1 + hstep, voffA);
            PG8_WAIT_V(8); PG8_WAIT_L(0); PG8_BAR; PG8_MMA(0, 0, At, B0); PG8_MMA(0, 1, At, B1); PG8_BAR; PG8_SCHED;
            PG8_LDA(At, 0, 1); PG8_STAGE(PG8_SB(0, 0), b2, voffB); PG8_STAGE(PG8_SB(0, 1), b2 + hstep, voffB); PG8_STAGE(PG8_SA(0, 0), a2, voffA);
            PG8_WAIT_V(8); PG8_WAIT_L(0); PG8_BAR; PG8_MMA(1, 0, At, B0); PG8_MMA(1, 1, At, B1); PG8_BAR; PG8_SCHED;
            PG8_LDB(B0, 1, 0); PG8_LDB(B1, 1, 1); PG8_SCHED; PG8_LDA(At, 1, 0); PG8_STAGE(PG8_SA(0, 1), a2 + hstep, voffA);
            PG8_WAIT_V(8); PG8_WAIT_L(0); PG8_BAR; PG8_MMA(0, 0, At, B0); PG8_MMA(0, 1, At, B1); PG8_BAR; PG8_SCHED;
            PG8_LDA(At, 1, 1); PG8_STAGE(PG8_SB(1, 0), b3, voffB); PG8_STAGE(PG8_SB(1, 1), b3 + hstep, voffB); PG8_STAGE(PG8_SA(1, 0), a3, voffA);
            PG8_WAIT_V(8); PG8_WAIT_L(0); PG8_BAR; PG8_MMA(1, 0, At, B0); PG8_MMA(1, 1, At, B1); PG8_BAR; PG8_SCHED;
            } else {
            PG8_LDB(B0, 0, 0); PG8_SCHED; PG8_LDA(At, 0, 0); PG8_STAGE(PG8_SA(1, 1), a1 + hstep, voffA);
            PG8_WAIT_L(8); PG8_BAR; PG8_WAIT_L(0); PG8_MMA(0, 0, At, B0); PG8_BAR; PG8_SCHED;
            PG8_LDB(B1, 0, 1); PG8_STAGE(PG8_SB(0, 0), b2, voffB);
            PG8_BAR; PG8_WAIT_L(0); PG8_MMA(0, 1, At, B1); PG8_BAR;
            PG8_LDA(At, 0, 1); PG8_STAGE(PG8_SA(0, 0), a2, voffA);
            PG8_BAR; PG8_WAIT_L(0); PG8_MMA(1, 0, At, B0); PG8_BAR; PG8_SCHED;
            PG8_STAGE(PG8_SB(0, 1), b2 + hstep, voffB);
            PG8_WAIT_V(6); PG8_BAR; PG8_MMA(1, 1, At, B1); PG8_BAR;
            PG8_LDB(B0, 1, 0); PG8_SCHED; PG8_LDA(At, 1, 0); PG8_STAGE(PG8_SA(0, 1), a2 + hstep, voffA);
            PG8_WAIT_L(8); PG8_BAR; PG8_WAIT_L(0); PG8_MMA(0, 0, At, B0); PG8_BAR; PG8_SCHED;
            PG8_LDB(B1, 1, 1); PG8_STAGE(PG8_SB(1, 0), b3, voffB);
            PG8_BAR; PG8_WAIT_L(0); PG8_MMA(0, 1, At, B1); PG8_BAR;
            PG8_LDA(At, 1, 1); PG8_STAGE(PG8_SA(1, 0), a3, voffA);
            PG8_BAR; PG8_WAIT_L(0); PG8_MMA(1, 0, At, B0); PG8_BAR; PG8_SCHED;
            PG8_STAGE(PG8_SB(1, 1), b3 + hstep, voffB);
            PG8_WAIT_V(6); PG8_BAR; PG8_MMA(1, 1, At, B1); PG8_BAR;
            }
        }
        if constexpr (ALIGN_EPI) { if (wr == 0) PG8_BAR; }
        if constexpr (!Epi::AFTER_DRAIN) { E(acc, cur, wr, wc, fr, fq); S.done(cur); }
#ifdef OPT_EPI2
        if constexpr (!Epi::AFTER_DRAIN && Epi::IDEMPOTENT) { E(acc, cur, wr, wc, fr, fq); }
#endif
        if (!has_next) break;
#pragma unroll
        for (int a = 0; a < 2; ++a)
#pragma unroll
            for (int b = 0; b < 2; ++b)
#pragma unroll
                for (int m = 0; m < 4; ++m)
#pragma unroll
                    for (int n = 0; n < 2; ++n) acc[a][b][m][n] = (f32x4){0.f, 0.f, 0.f, 0.f};
        cur = nxt; cA = nA; cB = nB; ++ui;
        if constexpr (ALIGN_EPI) { if (wr == 1) PG8_BAR; }
    }
    PG8_WAIT_V(0);
    if constexpr (!ALIGN_EPI) { if (wr == 0) PG8_BAR; }
    PG8_BAR;
    if constexpr (Epi::AFTER_DRAIN) { E.fused(acc, cur, wr, wc, fr, fq, lds, wid, lane); S.done(cur); }
#undef PG8_SA
#undef PG8_SB
#undef PG8_STAGE
#undef PG8_LDA
#undef PG8_LDB
#undef PG8_MMA
#undef PG8_WAIT_V
#undef PG8_WAIT_L
#undef PG8_BAR
#undef PG8_SCHED
}
}
#define GAS __attribute__((address_space(1)))
#define LAS __attribute__((address_space(3)))
typedef unsigned short bf16;
typedef unsigned v4u __attribute__((ext_vector_type(4)));
typedef float f32x4 __attribute__((ext_vector_type(4)));
typedef short bf16x8 __attribute__((ext_vector_type(8)));
typedef GAS unsigned gu32;
typedef GAS unsigned long long gu64;
#define RLX_AGENT __ATOMIC_RELAXED, __HIP_MEMORY_SCOPE_AGENT
#define LDS_WAIT() asm volatile("s_waitcnt lgkmcnt(0)" ::: "memory")
#define VM_WAIT() asm volatile("s_waitcnt vmcnt(0)" ::: "memory")
__device__ __forceinline__ unsigned long long rt() { return __builtin_amdgcn_s_memrealtime(); }
__device__ __forceinline__ unsigned f2bf(float f) { unsigned u = __builtin_bit_cast(unsigned, f); return (u + 0x7fffu + ((u >> 16) & 1u)) >> 16; }
__device__ __forceinline__ unsigned pk2(float lo, float hi) { return f2bf(lo) | (f2bf(hi) << 16); }

#define XB_TMO      128
#define XB_XCNT(j)  (256  + 64 * (j))
#define XB_XSUB(j)  (1280 + 64 * (j))
#define XB_XGEN(j)  (2304 + 64 * (j))
#define XB_TOP      3328
#define XB_TOPGEN   3392
#define XCD_BAR_WORDS 3456
#define XB_SPIN_CAP (1u << 18)

__device__ __forceinline__ unsigned xb_ld(unsigned* p)              { return __hip_atomic_load(p, __ATOMIC_RELAXED, __HIP_MEMORY_SCOPE_AGENT); }
__device__ __forceinline__ unsigned xb_add(unsigned* p, unsigned v) { return __hip_atomic_fetch_add(p, v, __ATOMIC_RELAXED, __HIP_MEMORY_SCOPE_AGENT); }
__device__ __forceinline__ unsigned xb_xcc_id() { return (unsigned)__builtin_amdgcn_s_getreg((3 << 11) | 20) & 0xFu; }
#define XB_SPIN(cond, bar) do { unsigned _sp = 0; while (cond) { __builtin_amdgcn_s_sleep(1); \
    if ((++_sp & 255u) == 0u) { if (xb_ld(&(bar)[XB_TMO])) break; if (_sp > XB_SPIN_CAP) { atomicAdd(&(bar)[XB_TMO], 1u); break; } } } } while (0)

struct XcdBarrier {
    unsigned* bar; unsigned x;
    volatile LAS unsigned* st;
};

__device__ __forceinline__ XcdBarrier xcd_barrier_post(unsigned* bar, volatile LAS unsigned* st) {
    XcdBarrier b; b.bar = bar; b.x = xb_xcc_id(); b.st = st;
    if (threadIdx.x == 0) (void)xb_add(&bar[XB_XCNT(b.x)], 1u);
    return b;
}
__device__ __forceinline__ void xcd_barrier_complete(unsigned* bar, unsigned x, unsigned& nloc, unsigned& nx) {
    const unsigned G = gridDim.x * gridDim.y * gridDim.z;
    unsigned sum, cnt, mine, sp = 0u;
    for (;;) {
        sum = 0u; cnt = 0u; mine = 0u;
#pragma unroll
        for (unsigned j = 0; j < 16; ++j) { const unsigned c = xb_ld(&bar[XB_XCNT(j)]); sum += c; cnt += (c > 0u) ? 1u : 0u; mine = (j == x) ? c : mine; }
        if (sum == G) break;
        __builtin_amdgcn_s_sleep(1);
        if ((++sp & 255u) == 0u) { if (xb_ld(&bar[XB_TMO])) break; if (sp > XB_SPIN_CAP) { atomicAdd(&bar[XB_TMO], 1u); break; } }
    }
    nloc = mine > 0u ? mine : 1u; nx = cnt > 0u ? cnt : 1u;
}

__device__ __forceinline__ void xcd_barrier(const XcdBarrier& b) {
    asm volatile("s_waitcnt vmcnt(0)" ::: "memory");
    __syncthreads();
    if (threadIdx.x == 0) {
        unsigned* bar = b.bar;
        __builtin_amdgcn_s_waitcnt(0);
        unsigned nloc = b.st[0], nx = b.st[1];
        if (nloc == 0u) { xcd_barrier_complete(bar, b.x, nloc, nx); b.st[0] = nloc; b.st[1] = nx; }
        const unsigned old = xb_add(&bar[XB_XSUB(b.x)], 1u);
        const unsigned gen = old / nloc;
        if (old + 1u == (gen + 1u) * nloc) {
            __builtin_amdgcn_fence(__ATOMIC_RELEASE, "agent");
            asm volatile("s_waitcnt vmcnt(0)" ::: "memory");
            const unsigned og = xb_add(&bar[XB_TOP], 1u);
            const unsigned tg = og / nx;
            if (og + 1u == (tg + 1u) * nx) xb_add(&bar[XB_TOPGEN], 1u);
            else XB_SPIN(xb_ld(&bar[XB_TOPGEN]) == tg, bar);
            __builtin_amdgcn_fence(__ATOMIC_ACQUIRE, "agent");
            xb_add(&bar[XB_XGEN(b.x)], 1u);
            asm volatile("s_waitcnt vmcnt(0)" ::: "memory");
        } else {
            XB_SPIN(xb_ld(&bar[XB_XGEN(b.x)]) == gen, bar);
            __builtin_amdgcn_fence(__ATOMIC_ACQUIRE, "agent");
            asm volatile("s_waitcnt vmcnt(0)" ::: "memory");
        }
    }
    __syncthreads();
}

constexpr int NWAVES = 8;
constexpr int BATCH = 4, SEQ = 4096, DM = 2048, DEPTH = 4, MIXW = 1024, INW = 12288, FFH = 5632;
constexpr int M = BATCH * SEQ;
constexpr int LDP = pg8::LDP;
constexpr int COL_LX = 0, COL_LG = 1024, COL_Q = 2048, COL_K = 3072, COL_V = 4096, COL_U = 5120, COL_G = 6144;
constexpr float NORM_EPS = 1e-6f;
constexpr float LOG2E = 1.4426950408889634f;

constexpr size_t MiB = 1u << 20;
constexpr size_t WS_CTL = 0, CTL_ZERO_BYTES = 1 * MiB;
constexpr size_t WS_PAR = 1 * MiB;
constexpr size_t WS_WIN = 9 * MiB;
constexpr size_t WS_WBR = WS_WIN + 192 * MiB;
constexpr size_t WS_WOUT = WS_WBR + 64 * MiB;
constexpr size_t WS_WGU = WS_WOUT + 32 * MiB;
constexpr size_t WS_WDN = WS_WGU + 176 * MiB;
constexpr size_t WS_H = WS_WDN + 88 * MiB;
constexpr size_t WS_PROJ = WS_H + 64 * MiB;
constexpr size_t WS_YA = WS_PROJ + 388 * MiB, WS_YB = WS_YA + 32 * MiB, WS_YC = WS_YB + 32 * MiB;
constexpr size_t WS_PB = WS_YC + 32 * MiB, WS_SB = WS_PB + 64 * MiB;
constexpr size_t WS_HID = WS_SB + 64 * MiB;
constexpr size_t WS_END = WS_HID + 176 * MiB;
constexpr int P_GMIX = 0, P_GBIAS = 2048, P_CONVW = 8192, P_CONVB = 12288, P_BA = 13312, P_BX = 14336, P_LAM = 15360, P_RELB = 16384, P_ARE = 18688, P_AIM = 22784, P_D = 26880, P_LOGSTEP = 27904,
              P_GFFN = 28160, P_WA = 30208, P_WX = 95744, P_BRE = 161280, P_BIM = 226816, P_CRE = 292352, P_CIM = 357888, P_GFIN = 423424, PAR_STRIDE = 425984;
static_assert((size_t)DEPTH * PAR_STRIDE * 4 <= 8 * MiB, "PAR");
constexpr int CW_BAR = 4096;
constexpr int CW_GRPX = 16384;
constexpr int CW_GRP = 8192;
static_assert(CW_BAR + XCD_BAR_WORDS <= CW_GRP && (CW_GRP + 64 * 64) <= CW_GRPX && (CW_GRPX + 256) * 4 <= (int)CTL_ZERO_BYTES, "CTL");

constexpr int RING_OFF = 0, RING_BYTES = 131072;
constexpr int LDSCTL_OFF = RING_BYTES, MISC_OFF = LDSCTL_OFF + 320, RINV_OFF = LDSCTL_OFF + 1024;
constexpr int LDS_BYTES = 147456;

typedef float f32x16 __attribute__((ext_vector_type(16)));
typedef short s16x4 __attribute__((ext_vector_type(4)));
typedef unsigned u32x2 __attribute__((ext_vector_type(2)));
using pg8::ex2; using pg8::rcp;

__device__ __forceinline__ float wave_sum(float v) {
#pragma unroll
    for (int o = 1; o < 64; o <<= 1) v += __shfl_xor(v, o);
    return v;
}
__device__ __forceinline__ unsigned cvtpk(float lo, float hi) { typedef __bf16 bf2_ __attribute__((ext_vector_type(2))); typedef float f2_ __attribute__((ext_vector_type(2))); const f2_ v_ = {lo, hi}; const bf2_ r_ = __builtin_convertvector(v_, bf2_); return __builtin_bit_cast(unsigned, r_); }
__device__ __forceinline__ float bf2f(bf16 v) { return __uint_as_float(((unsigned)v) << 16); }
__device__ __forceinline__ bf16 f2bf16(float f) { return (bf16)(cvtpk(f, 0.f) & 0xffffu); }

template <class F>
__device__ __forceinline__ void transpose_item(const float* W, int K, int N, bf16* WT, F drow, LAS float* scr, int item, int lane, const float* ksc = nullptr  ) {
    const int nblk = N / 32, kb = item / nblk, nb = item % nblk, k0 = 64 * kb, n0 = 32 * nb;
#pragma unroll 8
    for (int i = 0; i < 32; ++i) { const int kk = 2 * i + (lane >> 5); scr[kk * 33 + (lane & 31)] = W[(size_t)(k0 + kk) * N + n0 + (lane & 31)]; }
    LDS_WAIT(); asm volatile("" ::: "memory");
    const int c = lane & 7;
    const int r0 = drow(n0);
    f32x4 sa = {1.f, 1.f, 1.f, 1.f}, sb = sa;
    if (ksc) { sa = *(const GAS f32x4*)(ksc + k0 + 8 * c); sb = *(const GAS f32x4*)(ksc + k0 + 8 * c + 4); }
#pragma unroll
    for (int j = 0; j < 4; ++j) { const int n = (lane >> 3) + 8 * j; const LAS float* s = scr + (8 * c) * 33 + n;
        v4u o; o.x = cvtpk(s[0 * 33] * sa.x, s[1 * 33] * sa.y); o.y = cvtpk(s[2 * 33] * sa.z, s[3 * 33] * sa.w); o.z = cvtpk(s[4 * 33] * sb.x, s[5 * 33] * sb.y); o.w = cvtpk(s[6 * 33] * sb.z, s[7 * 33] * sb.w);
        *(GAS v4u*)(WT + (size_t)(r0 + n) * K + k0 + 8 * c) = o; }
    LDS_WAIT(); asm volatile("" ::: "memory");
}
struct RowId { __device__ __forceinline__ int operator()(int n) const { return n; } };
struct RowGU { int half; __device__ __forceinline__ int operator()(int n) const { return 256 * (n >> 7) + 128 * half + (n & 127); } };

__device__ __forceinline__ void rms_row_bf16(const float* xrow, const float* g, bf16* orow, int lane) {
    const GAS f32x4* xr = (const GAS f32x4*)xrow + lane; const GAS f32x4* gr = (const GAS f32x4*)g + lane;
    f32x4 v[8]; float s = 0.f;
#pragma unroll
    for (int j = 0; j < 8; ++j) { v[j] = xr[64 * j]; s += (v[j].x * v[j].x + v[j].y * v[j].y) + (v[j].z * v[j].z + v[j].w * v[j].w); }
    const float r = 1.0f / sqrtf(wave_sum(s) * (1.0f / DM) + NORM_EPS);
    GAS u32x2* o8 = (GAS u32x2*)orow + lane;
#pragma unroll
    for (int j = 0; j < 8; ++j) { const f32x4 gg = gr[64 * j]; u32x2 w; w.x = cvtpk(v[j].x * r * gg.x, v[j].y * r * gg.y); w.y = cvtpk(v[j].z * r * gg.z, v[j].w * r * gg.w); o8[64 * j] = w; }
}
__device__ __forceinline__ void row_bf16_ss(const float* xrow, bf16* orow, float* part, int m, int lane);
__device__ __forceinline__ void rms_row_f32(float* xrow, const float* g, int lane) {
    GAS f32x4* xr = (GAS f32x4*)xrow + lane; const GAS f32x4* gr = (const GAS f32x4*)g + lane;
    f32x4 v[8]; float s = 0.f;
#pragma unroll
    for (int j = 0; j < 8; ++j) { v[j] = xr[64 * j]; s += (v[j].x * v[j].x + v[j].y * v[j].y) + (v[j].z * v[j].z + v[j].w * v[j].w); }
    const float r = 1.0f / sqrtf(wave_sum(s) * (1.0f / DM) + NORM_EPS);
#pragma unroll
    for (int j = 0; j < 8; ++j) { const f32x4 gg = gr[64 * j]; xr[64 * j] = (v[j] * r) * gg; }
}

namespace att {
constexpr size_t SHM_V = 64 * 128 * 2, SHM_K = 64 * 128 * 2;
constexpr int OFF_WS = 2 * SHM_V + 2 * SHM_K, OFF_BT = OFF_WS + NWAVES * 64 * 4, ATT_LDS = OFF_BT + 320 * 4;
#define KSWZ(row, colB) ((row) * 256 + ((colB) ^ (((row) & 7) << 4)))
#define SBAR() __builtin_amdgcn_sched_barrier(0)
__device__ __forceinline__ int crow(int r, int hi) { return (r & 3) + 8 * (r >> 2) + 4 * hi; }
__device__ __forceinline__ void qkt(f32x16& p0, f32x16& p1, const char* Ks, const bf16x8* qr, int r32, int hi) {
    p0 = f32x16{}; p1 = f32x16{};
#pragma unroll
    for (int d0 = 0; d0 < 8; ++d0) { const int cb = (d0 * 16 + hi * 8) * 2;
        const bf16x8 b0 = *reinterpret_cast<const bf16x8*>(Ks + KSWZ(r32, cb));
        const bf16x8 b1 = *reinterpret_cast<const bf16x8*>(Ks + KSWZ(32 + r32, cb));
        p0 = __builtin_amdgcn_mfma_f32_32x32x16_bf16(b0, qr[d0], p0, 0, 0, 0);
        p1 = __builtin_amdgcn_mfma_f32_32x32x16_bf16(b1, qr[d0], p1, 0, 0, 0); }
}
__device__ __forceinline__ int v_st(int k, int c) { const int kk = (k & ~0xC) | ((k & 4) << 1) | ((k & 8) >> 1); return ((kk >> 3) * 4 + (c >> 5)) * 512 + ((kk & 7) * 32 + (c & 31)) * 2; }
__device__ __forceinline__ int v_rd_base(int lane) { return ((lane & 3) << 3) | (((lane >> 2) & 3) << 6) | (((lane >> 4) & 1) << 5) | (((lane >> 5) & 1) << 8); }
constexpr int v_rd_off(int d0, int ks, int half) { return d0 * 512 + ks * 4096 + half * 2048; }
template <int OFF> __device__ __forceinline__ s16x4 tr_read(int vb) {
    s16x4 r; asm volatile("ds_read_b64_tr_b16 %0, %1 offset:%2" : "=&v"(r) : "v"(vb), "i"(OFF) : "memory"); return r;
}
template <int D0> __device__ __forceinline__ void pv_one(f32x16& od, int vb, bf16x8 pa0, bf16x8 pa1, bf16x8 pa2, bf16x8 pa3) {
    const s16x4 l0 = tr_read<v_rd_off(D0, 0, 0)>(vb), h0 = tr_read<v_rd_off(D0, 0, 1)>(vb), l1 = tr_read<v_rd_off(D0, 1, 0)>(vb), h1 = tr_read<v_rd_off(D0, 1, 1)>(vb);
    const s16x4 l2 = tr_read<v_rd_off(D0, 2, 0)>(vb), h2 = tr_read<v_rd_off(D0, 2, 1)>(vb), l3 = tr_read<v_rd_off(D0, 3, 0)>(vb), h3 = tr_read<v_rd_off(D0, 3, 1)>(vb);
    asm volatile("s_waitcnt lgkmcnt(0)" ::: "memory"); SBAR();
#define PK(L, H) (bf16x8){L[0], L[1], L[2], L[3], H[0], H[1], H[2], H[3]}
    od = __builtin_amdgcn_mfma_f32_32x32x16_bf16(pa0, PK(l0, h0), od, 0, 0, 0);
    od = __builtin_amdgcn_mfma_f32_32x32x16_bf16(pa1, PK(l1, h1), od, 0, 0, 0);
    od = __builtin_amdgcn_mfma_f32_32x32x16_bf16(pa2, PK(l2, h2), od, 0, 0, 0);
    od = __builtin_amdgcn_mfma_f32_32x32x16_bf16(pa3, PK(l3, h3), od, 0, 0, 0);
#undef PK
}
__device__ __forceinline__ void tile_compute(f32x16 (&o)[4], float& m_reg, float& l_reg, const bf16x8 (&qr)[8], const char* Kbuf, int vb, const LAS float* bt, LAS float* al_l,
                                             int dc  , int qi  , int r32, int hi) {
    f32x16 p0, p1;
    qkt(p0, p1, Kbuf, qr, r32, hi);
    float bcv = 0.f;
    if (dc >= 3) bcv = bt[256];
    else { const LAS float* bp = bt + (64 * dc + qi + 128 - 4 * hi - 59);
#pragma unroll
        for (int r = 0; r < 16; ++r) p0[r] += bp[59 - ((r & 3) + 8 * (r >> 2))];
        SBAR();
#pragma unroll
        for (int r = 0; r < 16; ++r) p1[r] += bp[27 - ((r & 3) + 8 * (r >> 2))];
        SBAR(); }
    float pmax = p0[0];
#pragma unroll
    for (int r = 1; r < 16; ++r) pmax = fmaxf(pmax, p0[r]);
#pragma unroll
    for (int r = 0; r < 16; ++r) pmax = fmaxf(pmax, p1[r]);
    pmax = fmaxf(pmax, __shfl_xor(pmax, 32)) + bcv;
    const float mn = (pmax > m_reg + 8.0f) ? pmax : m_reg, alpha = ex2(m_reg - mn); m_reg = mn;
    const float mnb = mn - bcv;
    typedef float f2_ __attribute__((ext_vector_type(2)));
    const f2_ m2 = {mnb, mnb}; f2_ ps2 = {0.f, 0.f};
#pragma unroll
    for (int r = 0; r < 16; r += 2) {
        const f2_ a = (f2_){p0[r], p0[r + 1]} - m2, b = (f2_){p1[r], p1[r + 1]} - m2;
        p0[r] = ex2(a.x); p0[r + 1] = ex2(a.y); p1[r] = ex2(b.x); p1[r + 1] = ex2(b.y);
        ps2 += (f2_){p0[r], p0[r + 1]}; ps2 += (f2_){p1[r], p1[r + 1]}; }
    float ps = ps2.x + ps2.y;
    ps += __shfl_xor(ps, 32);
    l_reg = l_reg * alpha + ps;
    if (__any(alpha < 1.f)) { if (hi == 0) al_l[r32] = alpha; asm volatile("s_waitcnt lgkmcnt(0)" ::: "memory");
#pragma unroll
        for (int r = 0; r < 16; ++r) { const float a = al_l[crow(r, hi)];
#pragma unroll
            for (int d = 0; d < 4; ++d) o[d][r] *= a; }
        asm volatile("s_waitcnt lgkmcnt(0)" ::: "memory"); }
    bf16x8 pa0, pa1, pa2, pa3;
#define PK4(P, BASE, OUT) do { unsigned a0 = cvtpk(P[BASE + 0], P[BASE + 1]), a1 = cvtpk(P[BASE + 2], P[BASE + 3]);   \
    unsigned b0 = cvtpk(P[BASE + 4], P[BASE + 5]), b1 = cvtpk(P[BASE + 6], P[BASE + 7]);                              \
    auto r0 = __builtin_amdgcn_permlane32_swap(a0, b0, false, false); auto r1 = __builtin_amdgcn_permlane32_swap(a1, b1, false, false); \
    v4u w = {r0[0], r1[0], r0[1], r1[1]}; OUT = *reinterpret_cast<bf16x8*>(&w); } while (0)
    PK4(p0, 0, pa0); PK4(p0, 8, pa1); PK4(p1, 0, pa2); PK4(p1, 8, pa3);
#undef PK4
    pv_one<0>(o[0], vb, pa0, pa1, pa2, pa3); pv_one<1>(o[1], vb, pa0, pa1, pa2, pa3); pv_one<2>(o[2], vb, pa0, pa1, pa2, pa3); pv_one<3>(o[3], vb, pa0, pa1, pa2, pa3);
}

__device__ __forceinline__ void attn_unit(int b, int h, int qb, const bf16* __restrict__ proj, bf16* __restrict__ yb, const float* __restrict__ relb  , char* lds) {
    int tid_ = threadIdx.x; asm volatile("" : "+v"(tid_));
    const int tid = tid_, wid = tid >> 6, lane = tid & 63, r32 = lane & 31, hi = lane >> 5;
    char* V_lds = lds; char* K_lds = lds + 2 * SHM_V;
    LAS float* wsw = (LAS float*)(lds + OFF_WS) + wid * 64; LAS float* li_l = wsw; LAS float* al_l = wsw + 32;
    LAS float* bt = (LAS float*)(lds + OFF_BT);
    for (int i = tid; i < 320; i += NWAVES * 64) bt[i] = relb[i < 256 ? i : 256] * LOG2E;
    float m_reg = -1e30f, l_reg = 0.f; f32x16 o[4] = {}; bf16x8 qr[8];
    const size_t rowq = (size_t)b * SEQ + (size_t)qb * 256 + wid * 32 + r32;
    const bf16* Qw = proj + rowq * LDP + COL_Q + h * 128 + hi * 8;
#pragma unroll
    for (int d0 = 0; d0 < 8; ++d0) qr[d0] = *reinterpret_cast<const bf16x8*>(Qw + d0 * 16);
    const int cq = 4 * qb + (wid >> 1), qi = 32 * (wid & 1) + r32;
    const int kc_lo = (4 * qb - 8) > 0 ? (4 * qb - 8) : 0, NT = 4 * qb + 4 - kc_lo;
    const int my_lo = (cq - 8) > 0 ? (cq - 8) : 0;
    const int sr = tid >> 4, sc = (tid & 15) * 8, vst0 = v_st(sr, sc), vst1 = v_st(32 + sr, sc);
    const int vb0 = (int)(uintptr_t)V_lds + v_rd_base(lane);
    const bf16* Kg = proj + ((size_t)b * SEQ + sr) * LDP + COL_K + h * 128 + sc;
    const bf16* Vg = proj + ((size_t)b * SEQ + sr) * LDP + COL_V + h * 128 + sc;
    bf16x8 eV0, eV1, eK0, eK1, oV0, oV1, oK0, oK1;
#define SLOAD_E(kc) do { const size_t ro = (size_t)(kc) * 64 * LDP; eV0 = *(const bf16x8*)(Vg + ro); eV1 = *(const bf16x8*)(Vg + ro + 32 * (size_t)LDP); eK0 = *(const bf16x8*)(Kg + ro); eK1 = *(const bf16x8*)(Kg + ro + 32 * (size_t)LDP); } while (0)
#define SLOAD_O(kc) do { const size_t ro = (size_t)(kc) * 64 * LDP; oV0 = *(const bf16x8*)(Vg + ro); oV1 = *(const bf16x8*)(Vg + ro + 32 * (size_t)LDP); oK0 = *(const bf16x8*)(Kg + ro); oK1 = *(const bf16x8*)(Kg + ro + 32 * (size_t)LDP); } while (0)
#define SWRITE(bufi, v0, v1, k0, k1) do { *(bf16x8*)(V_lds + (bufi) * SHM_V + vst0) = v0; *(bf16x8*)(V_lds + (bufi) * SHM_V + vst1) = v1; \
    *(bf16x8*)(K_lds + (bufi) * SHM_K + KSWZ(sr, sc * 2)) = k0; *(bf16x8*)(K_lds + (bufi) * SHM_K + KSWZ(32 + sr, sc * 2)) = k1; } while (0)
    SLOAD_E(kc_lo); SWRITE(0, eV0, eV1, eK0, eK1); SLOAD_O(kc_lo + 1); SLOAD_E(kc_lo + 2);
    __syncthreads();
    for (int j = 0; j < NT; j += 2) {
        { const int kc = kc_lo + j; if (kc >= my_lo && kc <= cq) tile_compute(o, m_reg, l_reg, qr, K_lds, vb0, bt, al_l, cq - kc, qi, r32, hi); }
        SWRITE(1, oV0, oV1, oK0, oK1); if (j + 3 < NT) SLOAD_O(kc_lo + j + 3);
        __syncthreads();
        { const int kc = kc_lo + j + 1; if (kc >= my_lo && kc <= cq) tile_compute(o, m_reg, l_reg, qr, K_lds + SHM_K, vb0 + (int)SHM_V, bt, al_l, cq - kc, qi, r32, hi); }
        if (j + 2 < NT) { SWRITE(0, eV0, eV1, eK0, eK1); if (j + 4 < NT) SLOAD_E(kc_lo + j + 4); }
        __syncthreads();
    }
#undef SLOAD_E
#undef SLOAD_O
#undef SWRITE
    if (hi == 0) li_l[r32] = l_reg; asm volatile("s_waitcnt lgkmcnt(0)" ::: "memory");
    bf16* Ow = yb + ((size_t)b * SEQ + (size_t)qb * 256 + wid * 32) * MIXW + h * 128 + r32;
#pragma unroll
    for (int r = 0; r < 16; ++r) { const int orow = crow(r, hi); const float rl = rcp(li_l[orow]);
#pragma unroll
        for (int d0 = 0; d0 < 4; ++d0) Ow[(size_t)orow * MIXW + d0 * 32] = f2bf16(o[d0][r] * rl); }
    asm volatile("s_waitcnt lgkmcnt(0)" ::: "memory");
}
#undef KSWZ
}

__device__ __forceinline__ void store16_wt(void* p, v4u v) { asm volatile("global_store_dwordx4 %0, %1, off sc1\n\ts_nop 2" :: "v"(p), "v"(v) : "memory"); }

__device__ __forceinline__ void row_bf16_ss(const float* xrow, bf16* orow, float* part, int m, int lane) {
    const GAS f32x4* xr = (const GAS f32x4*)xrow + lane; f32x4 v[8]; float s = 0.f;
#pragma unroll
    for (int j = 0; j < 8; ++j) { v[j] = xr[64 * j]; s += (v[j].x * v[j].x + v[j].y * v[j].y) + (v[j].z * v[j].z + v[j].w * v[j].w); }
    s = wave_sum(s);
    GAS u32x2* o8 = (GAS u32x2*)orow + lane;
#pragma unroll
    for (int j = 0; j < 8; ++j) { u32x2 w; w.x = cvtpk(v[j].x, v[j].y); w.y = cvtpk(v[j].z, v[j].w); o8[64 * j] = w; }
    if (lane < 8) { v4u o = {lane == 0 ? __float_as_uint(s) : 0u, 0u, 0u, 0u}; store16_wt(part + ((size_t)lane * M + m) * 4, o); }
}
namespace s5 {
constexpr int XS_PITCH = 272;
constexpr int OFF_UT = 0, OFF_OT = 2048, OFF_XS = 4096, WAVE_BYTES = OFF_XS + 32 * XS_PITCH;
constexpr int OFF_ECH = NWAVES * WAVE_BYTES;
constexpr int S5_LDS = OFF_ECH + 2 * 8 * 64 * 8;
static_assert(S5_LDS <= RING_BYTES, "S5 LDS");
struct cplx { float r, i; };
__device__ __forceinline__ cplx cmul(cplx a, cplx b) { return cplx{a.r * b.r - a.i * b.i, a.r * b.i + a.i * b.r}; }
__device__ __forceinline__ cplx cfma(cplx a, cplx x, cplx y) { return cplx{a.r * x.r - a.i * x.i + y.r, a.r * x.i + a.i * x.r + y.i}; }
__device__ __forceinline__ cplx csel(bool c, cplx a, cplx b) { return cplx{c ? a.r : b.r, c ? a.i : b.i}; }
__device__ __forceinline__ cplx cxor32(cplx a) { return cplx{__shfl_xor(a.r, 32), __shfl_xor(a.i, 32)}; }

__device__ __forceinline__ void chain(int b, int g, const bf16* __restrict__ proj, bf16* __restrict__ yc,
                                      const float* __restrict__ a_re, const float* __restrict__ a_im, const float* __restrict__ b_re, const float* __restrict__ b_im,
                                      const float* __restrict__ c_re, const float* __restrict__ c_im, const float* __restrict__ dvec, const float* __restrict__ log_step, char* lds) {
    int tid_ = threadIdx.x; asm volatile("" : "+v"(tid_));
    const int tid = tid_, wid = tid >> 6, lane = tid & 63, r32 = lane & 31, hi = lane >> 5, hcol = lane & 15, q4 = lane >> 4;
    const float step = expf(log_step[g]);
    cplx lam[2], l16[2], l64[2]; bf16x8 Bre[2], Bim[2];
#pragma unroll
    for (int pt = 0; pt < 2; ++pt) { const int p = 32 * pt + r32; const float are = a_re[g * 64 + p], aim = a_im[g * 64 + p];
        const float mag = expf(are * step), ang = aim * step; float sn, cs; sincosf(ang, &sn, &cs);
        const float lbr = mag * cs, lbi = mag * sn; lam[pt] = cplx{lbr, lbi};
        cplx t = cmul(lam[pt], lam[pt]); t = cmul(t, t); t = cmul(t, t); t = cmul(t, t); l16[pt] = t; t = cmul(t, t); t = cmul(t, t); l64[pt] = t;
        const float den = are * are + aim * aim, nr = lbr - 1.0f, cre = (nr * are + lbi * aim) / den, cim = (lbi * are - nr * aim) / den;
        const f32x4* br4 = (const f32x4*)(b_re + (size_t)(g * 64 + p) * 16 + 8 * hi); const f32x4* bi4 = (const f32x4*)(b_im + (size_t)(g * 64 + p) * 16 + 8 * hi);
        const f32x4 br0 = br4[0], br1 = br4[1], bi0 = bi4[0], bi1 = bi4[1];
        float vr[8], vi[8];
#pragma unroll
        for (int j = 0; j < 4; ++j) { vr[j] = cre * br0[j] - cim * bi0[j]; vi[j] = cre * bi0[j] + cim * br0[j]; vr[4 + j] = cre * br1[j] - cim * bi1[j]; vi[4 + j] = cre * bi1[j] + cim * br1[j]; }
        v4u wr_ = {cvtpk(vr[0], vr[1]), cvtpk(vr[2], vr[3]), cvtpk(vr[4], vr[5]), cvtpk(vr[6], vr[7])}; Bre[pt] = *reinterpret_cast<bf16x8*>(&wr_);
        v4u wi_ = {cvtpk(vi[0], vi[1]), cvtpk(vi[2], vi[3]), cvtpk(vi[4], vi[5]), cvtpk(vi[6], vi[7])}; Bim[pt] = *reinterpret_cast<bf16x8*>(&wi_); }
    bf16x8 cc[4];
#pragma unroll
    for (int ks = 0; ks < 4; ++ks) { const int p0 = 16 * ks + 4 * q4; const f32x4 cr = *(const f32x4*)(c_re + (size_t)(g * 16 + hcol) * 64 + p0), ci = *(const f32x4*)(c_im + (size_t)(g * 16 + hcol) * 64 + p0);
        v4u w = {cvtpk(cr[0], -ci[0]), cvtpk(cr[1], -ci[1]), cvtpk(cr[2], -ci[2]), cvtpk(cr[3], -ci[3])}; cc[ks] = *reinterpret_cast<bf16x8*>(&w); }
    const float dh = dvec[g * 16 + hcol];
    char* wl = lds + wid * WAVE_BYTES; char* ut = wl + OFF_UT; char* ot = wl + OFF_OT; char* xs = wl + OFF_XS;
    const int tokA = 16 * ((r32 >> 2) & 1) + (r32 & 3) + 4 * (r32 >> 3);
    const bf16* uin = proj + ((size_t)b * SEQ + (lane >> 1)) * LDP + COL_U + 16 * g + 8 * (lane & 1);
    bf16* yout = yc + ((size_t)b * SEQ + (lane >> 1)) * MIXW + 16 * g + 8 * (lane & 1);
    const int tio = (lane >> 1) * 32 + 16 * (lane & 1);
    v4u pf0, pf1;
    { const size_t ro = (size_t)(64 * wid) * LDP; pf0 = *(const v4u*)(uin + ro); pf1 = *(const v4u*)(uin + ro + 32 * (size_t)LDP); }
    cplx Xr[2] = {cplx{0.f, 0.f}, cplx{0.f, 0.f}};
    for (int rd = 0; rd < 8; ++rd) {
        const int t0 = 64 * (8 * rd + wid);
        *(LAS v4u*)(ut + tio) = pf0; *(LAS v4u*)(ut + tio + 1024) = pf1;
        if (rd < 7) { const size_t ro = (size_t)(t0 + 512) * LDP; pf0 = *(const v4u*)(uin + ro); pf1 = *(const v4u*)(uin + ro + 32 * (size_t)LDP); }
        asm volatile("s_waitcnt lgkmcnt(0)" ::: "memory"); __builtin_amdgcn_wave_barrier();
        bf16x8 A[2];
#pragma unroll
        for (int tt = 0; tt < 2; ++tt) A[tt] = *(const LAS bf16x8*)(ut + (32 * tt + tokA) * 32 + 16 * hi);
        cplx E[2][2];
#pragma unroll
        for (int tt = 0; tt < 2; ++tt)
#pragma unroll
            for (int pt = 0; pt < 2; ++pt) {
                const f32x16 ur = __builtin_amdgcn_mfma_f32_32x32x16_bf16(A[tt], Bre[pt], f32x16{}, 0, 0, 0);
                const f32x16 ui = __builtin_amdgcn_mfma_f32_32x32x16_bf16(A[tt], Bim[pt], f32x16{}, 0, 0, 0);
                cplx e = cplx{0.f, 0.f};
#pragma unroll
                for (int r = 0; r < 16; ++r) e = cfma(lam[pt], e, cplx{ur[r], ui[r]});
                E[tt][pt] = e; }
        cplx Sg[4][2];
#pragma unroll
        for (int tt = 0; tt < 2; ++tt)
#pragma unroll
            for (int pt = 0; pt < 2; ++pt) { const cplx other = cxor32(E[tt][pt]); Sg[2 * tt][pt] = csel(hi == 0, E[tt][pt], other); Sg[2 * tt + 1][pt] = csel(hi == 0, other, E[tt][pt]); }
        LAS float* ech = (LAS float*)(lds + OFF_ECH) + (rd & 1) * (8 * 64 * 2);
#pragma unroll
        for (int pt = 0; pt < 2; ++pt) { cplx ec = Sg[0][pt]; ec = cfma(l16[pt], ec, Sg[1][pt]); ec = cfma(l16[pt], ec, Sg[2][pt]); ec = cfma(l16[pt], ec, Sg[3][pt]);
            if (hi == 0) { ech[(wid * 64 + 32 * pt + r32) * 2] = ec.r; ech[(wid * 64 + 32 * pt + r32) * 2 + 1] = ec.i; } }
        __syncthreads();
        cplx xin[2];
#pragma unroll
        for (int pt = 0; pt < 2; ++pt) { cplx x = Xr[pt]; xin[pt] = x;
#pragma unroll
            for (int w = 0; w < 8; ++w) { xin[pt] = csel(w == wid, x, xin[pt]); const cplx e = cplx{ech[(w * 64 + 32 * pt + r32) * 2], ech[(w * 64 + 32 * pt + r32) * 2 + 1]}; x = cfma(l64[pt], x, e); }
            Xr[pt] = x; }
#pragma unroll
        for (int tt = 0; tt < 2; ++tt) {
#pragma unroll
            for (int pt = 0; pt < 2; ++pt) {
                const cplx xb0 = xin[pt], xb1 = cfma(l16[pt], xb0, Sg[0][pt]), xb2 = cfma(l16[pt], xb1, Sg[1][pt]), xb3 = cfma(l16[pt], xb2, Sg[2][pt]);
                cplx x = (tt == 0) ? csel(hi == 0, xb0, xb1) : csel(hi == 0, xb2, xb3);
                bf16x8 a2 = A[tt]; asm volatile("" : "+v"(a2));
                const f32x16 ur = __builtin_amdgcn_mfma_f32_32x32x16_bf16(a2, Bre[pt], f32x16{}, 0, 0, 0);
                const f32x16 ui = __builtin_amdgcn_mfma_f32_32x32x16_bf16(a2, Bim[pt], f32x16{}, 0, 0, 0);
#pragma unroll
                for (int r = 0; r < 16; ++r) { x = cfma(lam[pt], x, cplx{ur[r], ui[r]});
                    *(LAS unsigned*)(xs + (16 * hi + r) * XS_PITCH + 4 * (32 * pt + r32)) = cvtpk(x.r, x.i); }
            }
            asm volatile("s_waitcnt lgkmcnt(0)" ::: "memory"); __builtin_amdgcn_wave_barrier();
#pragma unroll
            for (int mt = 0; mt < 2; ++mt) {
                float zz; asm volatile("v_mov_b32 %0, 0" : "=v"(zz)); f32x4 y4 = {zz, zz, zz, zz};
#pragma unroll
                for (int ks = 0; ks < 4; ++ks) { const bf16x8 a = *(const LAS bf16x8*)(xs + (16 * mt + hcol) * XS_PITCH + ks * 64 + q4 * 16);
                    y4 = __builtin_amdgcn_mfma_f32_16x16x32_bf16(a, cc[ks], y4, 0, 0, 0); }
#pragma unroll
                for (int r = 0; r < 4; ++r) { const int tok = 32 * tt + 16 * mt + 4 * q4 + r;
                    const float uv = bf2f(*(const LAS bf16*)(ut + tok * 32 + 2 * hcol));
                    *(LAS bf16*)(ot + tok * 32 + 2 * hcol) = f2bf16(pg8::gelu_tanh(y4[r] + dh * uv)); }
            }
            asm volatile("s_waitcnt lgkmcnt(0)" ::: "memory"); __builtin_amdgcn_wave_barrier();
        }
        { const v4u o0 = *(const LAS v4u*)(ot + tio), o1 = *(const LAS v4u*)(ot + tio + 1024);
          store16_wt(yout + (size_t)t0 * MIXW, o0); store16_wt(yout + (size_t)(t0 + 32) * MIXW, o1); }
        asm volatile("s_waitcnt lgkmcnt(0)" ::: "memory"); __builtin_amdgcn_wave_barrier();
    }
    asm volatile("s_waitcnt vmcnt(0)" ::: "memory");
    __syncthreads();
}
}

namespace lru {
constexpr int XT_PITCH = 144;
constexpr int OFF_XT = 0, XT_BYTES = 72 * XT_PITCH, OFF_GT = XT_BYTES, OFF_OT = OFF_GT + 2048, WAVE_BYTES = OFF_OT + 2048;
constexpr int OFF_AG = NWAVES * WAVE_BYTES;
constexpr int LRU_LDS = OFF_AG + 2 * 32 * 16 * 8;
static_assert(LRU_LDS <= RING_BYTES, "LRU LDS");
__device__ __forceinline__ void chain(int b, int n, int qd, const bf16* __restrict__ proj, bf16* __restrict__ ya,
                                      const float* __restrict__ conv_w, const float* __restrict__ conv_b, const float* __restrict__ wa, const float* __restrict__ ba,
                                      const float* __restrict__ wx, const float* __restrict__ bx, const float* __restrict__ lamp, char* lds) {
    int tid_ = threadIdx.x; asm volatile("" : "+v"(tid_));
    const int tid = tid_, wid = tid >> 6, lane = tid & 63, jc = lane & 15, q4 = lane >> 4, cp = lane & 31, hh = lane >> 5;
    const int cho = 64 * n + 16 * qd + jc;
    const int chp = 64 * n + 2 * cp;
    const float spl = log1pf(expf(-lamp[cho])), c8l = -8.0f * spl * LOG2E;
    const float bao = ba[cho], bxo = bx[cho];
    const float wo0 = conv_w[0 * MIXW + cho], wo1 = conv_w[1 * MIXW + cho], wo2 = conv_w[2 * MIXW + cho], wo3 = conv_w[3 * MIXW + cho], cbo = conv_b[cho];
    float wp[4][2], cbp[2];
#pragma unroll
    for (int e = 0; e < 2; ++e) { cbp[e] = conv_b[chp + e];
#pragma unroll
        for (int k = 0; k < 4; ++k) wp[k][e] = conv_w[k * MIXW + chp + e]; }
    bf16x8 Ba[2], Bx[2];
#pragma unroll
    for (int ks = 0; ks < 2; ++ks) { float va[8], vx[8];
#pragma unroll
        for (int j = 0; j < 8; ++j) { const size_t idx = ((size_t)n * 64 + 32 * ks + 8 * q4 + j) * 64 + 16 * qd + jc; va[j] = wa[idx]; vx[j] = wx[idx]; }
        v4u w0 = {cvtpk(va[0], va[1]), cvtpk(va[2], va[3]), cvtpk(va[4], va[5]), cvtpk(va[6], va[7])}; Ba[ks] = *reinterpret_cast<bf16x8*>(&w0);
        v4u w1 = {cvtpk(vx[0], vx[1]), cvtpk(vx[2], vx[3]), cvtpk(vx[4], vx[5]), cvtpk(vx[6], vx[7])}; Bx[ks] = *reinterpret_cast<bf16x8*>(&w1); }
    char* wl = lds + wid * WAVE_BYTES; char* xt = wl + OFF_XT; char* gt = wl + OFF_GT; char* ot = wl + OFF_OT;
    const bf16* xin = proj + (size_t)b * SEQ * LDP + COL_LX + 64 * n + 8 * (lane & 7);
    const bf16* gin = proj + ((size_t)b * SEQ + (lane >> 1)) * LDP + COL_LG + 64 * n + 16 * qd + 8 * (lane & 1);
    bf16* yout = ya + ((size_t)b * SEQ + (lane >> 1)) * MIXW + 64 * n + 16 * qd + 8 * (lane & 1);
    const int tio = (lane >> 1) * 32 + 16 * (lane & 1), xio = (lane >> 3) * XT_PITCH + 16 * (lane & 7);
    v4u px[9], pg0, pg1;
#define LRU_PREFETCH(T0) do { _Pragma("unroll") for (int j = 0; j < 9; ++j) { int t = (T0) - 3 + 8 * j + (lane >> 3); t = t > (T0) + 63 ? (T0) + 63 : t; \
            px[j] = (t >= 0) ? *(const v4u*)(xin + (size_t)t * LDP) : (v4u){0u, 0u, 0u, 0u}; } \
        pg0 = *(const v4u*)(gin + (size_t)(T0) * LDP); pg1 = *(const v4u*)(gin + (size_t)((T0) + 32) * LDP); } while (0)
    LRU_PREFETCH(64 * wid);
    float Cr = 0.f;
    for (int rd = 0; rd < 8; ++rd) {
        const int t0 = 64 * (8 * rd + wid);
#pragma unroll
        for (int j = 0; j < 9; ++j) *(LAS v4u*)(xt + 8 * j * XT_PITCH + xio) = px[j];
        *(LAS v4u*)(gt + tio) = pg0; *(LAS v4u*)(gt + tio + 1024) = pg1;
        if (rd < 7) LRU_PREFETCH(t0 + 512);
        asm volatile("s_waitcnt lgkmcnt(0)" ::: "memory"); __builtin_amdgcn_wave_barrier();
        float xcf[16];
        { float xw[19];
#pragma unroll
          for (int k = 0; k < 19; ++k) xw[k] = bf2f(*(const LAS bf16*)(xt + (16 * q4 + k) * XT_PITCH + 2 * (16 * qd + jc)));
#pragma unroll
          for (int k = 0; k < 16; ++k) xcf[k] = cbo + wo0 * xw[k] + wo1 * xw[k + 1] + wo2 * xw[k + 2] + wo3 * xw[k + 3]; }
        { unsigned rw[35];
#pragma unroll
          for (int k = 0; k < 35; ++k) rw[k] = *(const LAS unsigned*)(xt + (32 * hh + k) * XT_PITCH + 4 * cp);
          asm volatile("s_waitcnt lgkmcnt(0)" ::: "memory"); __builtin_amdgcn_wave_barrier();
#pragma unroll
          for (int k = 0; k < 32; ++k) {
              const float c0 = cbp[0] + wp[0][0] * pg8::bf_lo(rw[k]) + wp[1][0] * pg8::bf_lo(rw[k + 1]) + wp[2][0] * pg8::bf_lo(rw[k + 2]) + wp[3][0] * pg8::bf_lo(rw[k + 3]);
              const float c1 = cbp[1] + wp[0][1] * pg8::bf_hi(rw[k]) + wp[1][1] * pg8::bf_hi(rw[k + 1]) + wp[2][1] * pg8::bf_hi(rw[k + 2]) + wp[3][1] * pg8::bf_hi(rw[k + 3]);
              *(LAS unsigned*)(xt + (32 * hh + k + 3) * XT_PITCH + 4 * cp) = cvtpk(c0, c1); } }
        asm volatile("s_waitcnt lgkmcnt(0)" ::: "memory"); __builtin_amdgcn_wave_barrier();
        f32x4 ga[4], gx[4];
#pragma unroll
        for (int i = 0; i < 4; ++i) { const int tok = 16 * (jc >> 2) + 4 * i + (jc & 3);
            const bf16x8 a0 = *(const LAS bf16x8*)(xt + (tok + 3) * XT_PITCH + (0 + 8 * q4) * 2), a1 = *(const LAS bf16x8*)(xt + (tok + 3) * XT_PITCH + (32 + 8 * q4) * 2);
            float zz; asm volatile("v_mov_b32 %0, 0" : "=v"(zz)); f32x4 za = {zz, zz, zz, zz}, zx = {zz, zz, zz, zz};
            za = __builtin_amdgcn_mfma_f32_16x16x32_bf16(a0, Ba[0], za, 0, 0, 0); za = __builtin_amdgcn_mfma_f32_16x16x32_bf16(a1, Ba[1], za, 0, 0, 0);
            zx = __builtin_amdgcn_mfma_f32_16x16x32_bf16(a0, Bx[0], zx, 0, 0, 0); zx = __builtin_amdgcn_mfma_f32_16x16x32_bf16(a1, Bx[1], zx, 0, 0, 0);
            ga[i] = za; gx[i] = zx; }
        float hl[16], Pc[16];
        { float h = 0.f, P = 1.f;
#pragma unroll
          for (int k = 0; k < 16; ++k) { const float r = pg8::sigmoidf_(ga[k >> 2][k & 3] + bao), ig = pg8::sigmoidf_(gx[k >> 2][k & 3] + bxo);
              const float a = pg8::ex2(c8l * r); const float mult = __builtin_amdgcn_sqrtf(fmaxf(1.0f - a * a, 0.f));
              h = a * h + mult * (ig * xcf[k]); P = a * P; hl[k] = h; Pc[k] = P; }
          LAS float* ag = (LAS float*)(lds + OFF_AG) + (rd & 1) * (32 * 16 * 2);
          ag[((4 * wid + q4) * 16 + jc) * 2] = P; ag[((4 * wid + q4) * 16 + jc) * 2 + 1] = h; }
        __syncthreads();
        float cin = 0.f;
        { const LAS float* ag = (const LAS float*)(lds + OFF_AG) + (rd & 1) * (32 * 16 * 2); const int myseg = 4 * wid + q4; float c = Cr;
#pragma unroll 8
          for (int s = 0; s < 32; ++s) { cin = (s == myseg) ? c : cin; c = ag[(s * 16 + jc) * 2] * c + ag[(s * 16 + jc) * 2 + 1]; }
          Cr = c; }
#pragma unroll
        for (int k = 0; k < 16; ++k) { const int tok = 16 * q4 + k; const float h = hl[k] + Pc[k] * cin; const float gv = bf2f(*(const LAS bf16*)(gt + tok * 32 + 2 * jc));
            *(LAS bf16*)(ot + tok * 32 + 2 * jc) = f2bf16(h * gv); }
        asm volatile("s_waitcnt lgkmcnt(0)" ::: "memory"); __builtin_amdgcn_wave_barrier();
        { const v4u o0 = *(const LAS v4u*)(ot + tio), o1 = *(const LAS v4u*)(ot + tio + 1024);
          store16_wt(yout + (size_t)t0 * MIXW, o0); store16_wt(yout + (size_t)(t0 + 32) * MIXW, o1); }
        asm volatile("s_waitcnt lgkmcnt(0)" ::: "memory"); __builtin_amdgcn_wave_barrier();
    }
#undef LRU_PREFETCH
    asm volatile("s_waitcnt vmcnt(0)" ::: "memory");
    __syncthreads();
}
}

#ifndef MK_N_LAUNCHES
#define MK_N_LAUNCHES 1
#endif
#ifndef REP_PRO
#define REP_PRO 1
#endif
#ifndef REP_MIX
#define REP_MIX 1
#endif
#ifndef REP_ATT
#define REP_ATT 1
#endif
#ifndef REP_S5
#define REP_S5 1
#endif
#ifndef REP_LRU
#define REP_LRU 1
#endif
#ifndef REP_G3
#define REP_G3 1
#endif
#ifndef REP_G6
#define REP_G6 1
#endif
#ifndef ALIGN_BR
#define ALIGN_BR true
#endif
#ifndef ALIGN_RES
#define ALIGN_RES true
#endif
#ifndef REP_RMS
#define REP_RMS 1
#endif
#ifndef REP_G0
#define REP_G0 1
#endif
#ifndef REP_G2
#define REP_G2 1
#endif
#ifndef REP_G5
#define REP_G5 1
#endif
#ifndef OPT_GROUPS
#define OPT_GROUPS 1
#endif
constexpr int N_PHASES = 1 + 9 * DEPTH;
constexpr bool ONE_LAUNCH = (MK_N_LAUNCHES == 1);
struct Args { const float* in[28]; float* out; unsigned char* ws; int ph_lo, ph_hi; };

__device__ __forceinline__ int opq_zero() { int z; asm volatile("s_mov_b32 %0, 0" : "=s"(z)); return z; }
__device__ __forceinline__ void group_barrier(unsigned* cnt, unsigned target, unsigned* xbar, volatile LAS unsigned* same_xcc) {
    asm volatile("s_waitcnt vmcnt(0)" ::: "memory");
    __syncthreads();
    if (threadIdx.x == 0) {
        if (*same_xcc == 0u) {
            __builtin_amdgcn_fence(__ATOMIC_RELEASE, "agent");
            asm volatile("s_waitcnt vmcnt(0)" ::: "memory"); }
        (void)xb_add(cnt, 1u);
        XB_SPIN(xb_ld(cnt) < target, xbar);
        __builtin_amdgcn_fence(__ATOMIC_ACQUIRE, "agent");
        asm volatile("s_waitcnt vmcnt(0)" ::: "memory");
    }
    __syncthreads();
}
__global__ void __launch_bounds__(NWAVES * 64, 2) fwd_kernel(Args args) {
    extern __shared__ __attribute__((aligned(16))) unsigned char lds[];
    const int tid = threadIdx.x;
    const int G = gridDim.x, bx = blockIdx.x;
    gu32* ctl = (gu32*)(args.ws + WS_CTL);
    for (int u = tid; u < (LDS_BYTES - LDSCTL_OFF) / 4; u += NWAVES * 64) ((LAS unsigned*)((LAS unsigned char*)lds + LDSCTL_OFF))[u] = 0u;
    __syncthreads();
    volatile LAS unsigned* MISC = (volatile LAS unsigned*)((LAS unsigned char*)lds + MISC_OFF);
    XcdBarrier bar; bar.bar = (unsigned*)(ctl + CW_BAR); bar.x = 0; bar.st = nullptr;
    if (ONE_LAUNCH) bar = xcd_barrier_post((unsigned*)(ctl + CW_BAR), MISC + 8);
    const int lo = args.ph_lo, hi = args.ph_hi;
    if (ONE_LAUNCH && OPT_GROUPS && G == 256 && tid == 0)
        __hip_atomic_store((unsigned*)(ctl + CW_GRPX) + 4 * (8 * (bx & 7) + ((bx >> 3) & 7)) + (bx >> 6), xb_xcc_id() + 1u, __ATOMIC_RELAXED, __HIP_MEMORY_SCOPE_AGENT);
#ifdef DBG_INV
    __builtin_amdgcn_fence(__ATOMIC_ACQUIRE, "agent"); asm volatile("s_waitcnt vmcnt(0)" ::: "memory"); __syncthreads();
#endif
#define IN(k) (lo <= (k) && (k) < hi)
#ifndef DBG_MHZ
#define DBG_MHZ 0
#endif
#ifdef DBG_T_LO
#define TSTAMP(k) do { int t_ = threadIdx.x; asm volatile("" : "+v"(t_)); if (((k) == DBG_T_LO || (k) == DBG_T_HI) && blockIdx.x == 0 && t_ == 0) { \
        if ((k) == DBG_T_LO) { const unsigned long long r_ = wall_clock64(), c_ = clock64(); MISC[18] = (unsigned)r_; MISC[19] = (unsigned)(r_ >> 32); MISC[16] = (unsigned)c_; MISC[17] = (unsigned)(c_ >> 32); } \
        if ((k) == DBG_T_HI) { const unsigned long long r0_ = ((unsigned long long)MISC[19] << 32) | MISC[18], c0_ = ((unsigned long long)MISC[17] << 32) | MISC[16]; \
            const unsigned long long dr_ = wall_clock64() - r0_, dc_ = clock64() - c0_; MISC[21] = DBG_MHZ ? (unsigned)(dc_ * 10000ull / (dr_ ? dr_ : 1ull)) : (unsigned)dr_; } } } while (0)
#else
#define TSTAMP(k) do { } while (0)
#endif
#ifdef OPT_BAR2
#define SEAM(k) do { if (ONE_LAUNCH && IN(k) && IN((k) + 1)) { xcd_barrier(bar); xcd_barrier(bar); } } while (0)
#else
#define SEAM(k) do { if (ONE_LAUNCH && IN(k) && IN((k) + 1)) xcd_barrier(bar); } while (0)
#endif

    const int NGW = G * NWAVES;
#define GSEAM(k, s) do { if (ONE_LAUNCH && IN(k) && IN((k) + 1)) { if (OPT_GROUPS && G == 256) group_barrier((unsigned*)(ctl + CW_GRP) + 64 * (8 * (bx & 7) + ((bx >> 3) & 7)), 4u * (unsigned)(5 * l + (s) + 1), bar.bar, MISC + 24); else xcd_barrier(bar); } } while (0)
#define LANEW() int tl_ = threadIdx.x; asm volatile("" : "+v"(tl_)); const int lane = tl_ & 63, wave = __builtin_amdgcn_readfirstlane(tl_ >> 6), gw = bx * NWAVES + wave; (void)lane; (void)gw;
#define OPQ(p) ((p) + opq_zero())
#define PTRS() unsigned char* ws = OPQ(args.ws); float* X = OPQ(args.out); const float* x_in = OPQ(args.in[0]); \
    bf16* Hn = (bf16*)(ws + WS_H); bf16* PROJ = (bf16*)(ws + WS_PROJ); bf16* HID = (bf16*)(ws + WS_HID); \
    bf16* YA = (bf16*)(ws + WS_YA); bf16* YB = (bf16*)(ws + WS_YB); bf16* YC = (bf16*)(ws + WS_YC); bf16* PB = (bf16*)(ws + WS_PB); bf16* SB = (bf16*)(ws + WS_SB); \
    float* PAR = (float*)(ws + WS_PAR); const float* PL = PAR + (size_t)l * PAR_STRIDE; float* PART = (float*)(ws + WS_SB); (void)PART; \
    (void)X; (void)x_in; (void)Hn; (void)PROJ; (void)HID; (void)YA; (void)YB; (void)YC; (void)PB; (void)SB; (void)PL;

    LAS float* RINV = (LAS float*)((LAS unsigned char*)lds + RINV_OFF);
#define RINV_PASS() do { int t_ = threadIdx.x; asm volatile("" : "+v"(t_)); if (t_ < 256) { const size_t row_ = (size_t)256 * (8 * (bx & 7) + ((bx >> 3) & 7)) + t_; float s_ = 0.f; \
        _Pragma("unroll") for (int pn_ = 0; pn_ < 8; ++pn_) { const f32x4 p_ = *(const GAS f32x4*)(PART + ((size_t)pn_ * M + row_) * 4); s_ += (p_.x + p_.y) + (p_.z + p_.w); } \
        RINV[t_] = 1.0f / sqrtf(s_ * (1.0f / DM) + NORM_EPS); } __syncthreads(); } while (0)

    TSTAMP(0);
#ifndef NO_PRO
    if (IN(0)) for (int rep_ = 0; rep_ < REP_PRO; ++rep_) {
        const int l = 0; PTRS(); LANEW();
        LAS float* scr = (LAS float*)((LAS unsigned char*)lds + RING_OFF + wave * 16384);
        constexpr int I_IN = (DM / 64) * (INW / 32), I_BR = (MIXW / 64) * (DM / 32), I_OUT = (DM / 64) * (DM / 32), I_G = (DM / 64) * (FFH / 32), I_DN = (FFH / 64) * (DM / 32);
        constexpr int I_LAYER = I_IN + 4 * I_BR + I_OUT + 2 * I_G + I_DN;
        for (int it = gw; it < DEPTH * I_LAYER; it += NGW) {
            const int l = it / I_LAYER; int r = it % I_LAYER;
            if (r < I_IN) { transpose_item(args.in[2] + (size_t)l * DM * INW, DM, INW, (bf16*)(ws + WS_WIN) + (size_t)l * INW * DM, RowId{}, scr, r, lane, args.in[1] + (size_t)l * DM); continue; } r -= I_IN;
            if (r < 2 * I_BR) { const int br = r / I_BR;
                transpose_item(args.in[21] + ((size_t)l * 3 + br) * MIXW * DM, MIXW, DM, (bf16*)(ws + WS_WBR) + ((size_t)l * 4 + br) * DM * MIXW, RowId{}, scr, r % I_BR, lane); continue; } r -= 2 * I_BR;
            if (r < I_BR) { transpose_item(args.in[21] + ((size_t)l * 3 + 2) * MIXW * DM, MIXW, DM, (bf16*)(ws + WS_WBR) + ((size_t)l * 4 + 2) * DM * MIXW, RowGU{0}, scr, r, lane); continue; } r -= I_BR;
            if (r < I_BR) { transpose_item(args.in[20] + (size_t)l * MIXW * DM, MIXW, DM, (bf16*)(ws + WS_WBR) + ((size_t)l * 4 + 2) * DM * MIXW, RowGU{1}, scr, r, lane); continue; } r -= I_BR;
            if (r < I_OUT) { transpose_item(args.in[22] + (size_t)l * DM * DM, DM, DM, (bf16*)(ws + WS_WOUT) + (size_t)l * DM * DM, RowId{}, scr, r, lane); continue; } r -= I_OUT;
            if (r < I_G) { transpose_item(args.in[24] + (size_t)l * DM * FFH, DM, FFH, (bf16*)(ws + WS_WGU) + (size_t)l * 2 * FFH * DM, RowGU{0}, scr, r, lane, args.in[23] + (size_t)l * DM); continue; } r -= I_G;
            if (r < I_G) { transpose_item(args.in[25] + (size_t)l * DM * FFH, DM, FFH, (bf16*)(ws + WS_WGU) + (size_t)l * 2 * FFH * DM, RowGU{1}, scr, r, lane, args.in[23] + (size_t)l * DM); continue; } r -= I_G;
            transpose_item(args.in[26] + (size_t)l * FFH * DM, FFH, DM, (bf16*)(ws + WS_WDN) + (size_t)l * DM * FFH, RowId{}, scr, r, lane);
        }
        { const int gt = bx * (NWAVES * 64) + tl_, gs = G * (NWAVES * 64);
#define PCOPY(k, cnt, off) for (int i = gt; i < DEPTH * (cnt); i += gs) __hip_atomic_store(PAR + (size_t)(i / (cnt)) * PAR_STRIDE + (off) + (i % (cnt)), args.in[k][i], __ATOMIC_RELAXED, __HIP_MEMORY_SCOPE_AGENT)
          PCOPY(1, 2048, P_GMIX); PCOPY(3, 6144, P_GBIAS); PCOPY(4, 4096, P_CONVW); PCOPY(5, 1024, P_CONVB); PCOPY(7, 1024, P_BA); PCOPY(9, 1024, P_BX); PCOPY(10, 1024, P_LAM); PCOPY(11, 2056, P_RELB);
          PCOPY(12, 4096, P_ARE); PCOPY(13, 4096, P_AIM); PCOPY(18, 1024, P_D); PCOPY(19, 64, P_LOGSTEP); PCOPY(23, 2048, P_GFFN); PCOPY(6, 65536, P_WA); PCOPY(8, 65536, P_WX);
          PCOPY(14, 65536, P_BRE); PCOPY(15, 65536, P_BIM); PCOPY(16, 65536, P_CRE); PCOPY(17, 65536, P_CIM);
#undef PCOPY
          for (int i = gt; i < 2048; i += gs) __hip_atomic_store(PAR + P_GFIN + i, args.in[27][i], __ATOMIC_RELAXED, __HIP_MEMORY_SCOPE_AGENT); }
        for (int m = gw; m < M; m += NGW) row_bf16_ss(x_in + (size_t)m * DM, Hn + (size_t)m * DM, PART, m, lane);
    }
#endif
    SEAM(0);
    if (ONE_LAUNCH && OPT_GROUPS && G == 256) {
        int t_ = threadIdx.x; asm volatile("" : "+v"(t_));
        if (t_ == 0) { unsigned* gx = (unsigned*)(ctl + CW_GRPX) + 4 * (8 * (bx & 7) + ((bx >> 3) & 7)); const unsigned a0 = xb_ld(gx), a1 = xb_ld(gx + 1), a2 = xb_ld(gx + 2), a3 = xb_ld(gx + 3);
            MISC[24] = (a0 != 0u && a0 == a1 && a0 == a2 && a0 == a3) ? 1u : 0u; } }
#ifdef DBG_G0NULL
    { const int l = 0; PTRS();
      if (DBG_G0NULL == 1) { pg8::Gemm g{Hn, (const bf16*)(ws + WS_WIN), M, INW, DM}; pg8::StaticOrder S; S.init(M, INW, G, bx); pg8::EpiNull E2{}; pg8::gemm_phase<pg8::EpiNull, pg8::StaticOrder, true, true>((LAS unsigned char*)lds + RING_OFF, g, S, E2); }
      else { pg8::Gemm g{Hn, (const bf16*)(ws + WS_WGU), M, 2 * FFH, DM}; pg8::StaticOrder S; S.init(M, 2 * FFH, G, bx); pg8::EpiNull E2{}; pg8::gemm_phase<pg8::EpiNull, pg8::StaticOrder, true, true>((LAS unsigned char*)lds + RING_OFF, g, S, E2); } }
#endif

    for (int l = 0; l < DEPTH; ++l) {
        const int P = 1 + 9 * l;
        TSTAMP(P + 0);
#ifndef NO_G0
        if (IN(P + 0)) for (int rep_ = 0; rep_ < REP_G0; ++rep_) {
            PTRS();
            pg8::Gemm g{Hn, (const bf16*)(ws + WS_WIN) + (size_t)l * INW * DM, M, INW, DM}; pg8::StaticOrder S; S.init(M, INW, G, bx);
            RINV_PASS();
            pg8::EpiIn E{PROJ, PL + P_GBIAS, RINV};
            pg8::gemm_phase<pg8::EpiIn, pg8::StaticOrder, true, true>((LAS unsigned char*)lds + RING_OFF, g, S, E);
#ifdef DBG_G0ALT
            { pg8::EpiSwiglu E2{YA, RINV}; pg8::gemm_phase<pg8::EpiSwiglu, pg8::StaticOrder, true, true>((LAS unsigned char*)lds + RING_OFF, g, S, E2); }
#endif
        }
#endif
        SEAM(P + 0);
        TSTAMP(P + 1);
        if (IN(P + 1)) for (int rep_ = 0; rep_ < REP_MIX; ++rep_) {
            PTRS();
#if defined(NO_ATT) || defined(NO_S5) || defined(NO_LRU)
            { LANEW(); v4u z = {0u, 0u, 0u, 0u};
              for (size_t i = (size_t)bx * 512 + tl_; i < (size_t)M * MIXW / 8; i += (size_t)G * 512) {
#ifdef NO_ATT
                  ((v4u*)YB)[i] = z;
#endif
#ifdef NO_S5
                  ((v4u*)YC)[i] = z;
#endif
#ifdef NO_LRU
                  ((v4u*)YA)[i] = z;
#endif
              } }
#endif
#ifndef NO_ATT
            for (int rr_ = 0; rr_ < REP_ATT; ++rr_)
            for (int i = bx; i < 512; i += G) {
                const int j = i & 255, kq = j >> 3, xc_ = j & 7, bh = 8 * (xc_ >> 1) + (kq & 7), qb = 8 * (xc_ & 1) + ((i < 256) ? 7 - (kq >> 3) : (kq >> 3));
                att::attn_unit(bh >> 3, bh & 7, qb, PROJ, YB, PL + P_RELB + (bh & 7) * 257, (char*)lds + RING_OFF);
            }
#endif
            __syncthreads();
            TSTAMP(200 + 8 * l + 0);
#ifndef NO_S5
            for (int rr_ = 0; rr_ < REP_S5; ++rr_)
            for (int i = bx; i < 256; i += G)
                s5::chain((i & 7) >> 1, 32 * (i & 1) + (i >> 3), PROJ, YC,     PL + P_ARE, PL + P_AIM, PL + P_BRE, PL + P_BIM,
                          PL + P_CRE, PL + P_CIM, PL + P_D, PL + P_LOGSTEP, (char*)lds + RING_OFF);
#endif
            TSTAMP(200 + 8 * l + 1);
#ifndef NO_LRU
            for (int rr_ = 0; rr_ < REP_LRU; ++rr_)
            for (int i = bx; i < 256; i += G)
                lru::chain((i & 7) >> 1, 8 * (i & 1) + (i >> 5), (i >> 3) & 3, PROJ, YA,     PL + P_CONVW, PL + P_CONVB, PL + P_WA, PL + P_BA,
                           PL + P_WX, PL + P_BX, PL + P_LAM, (char*)lds + RING_OFF);
#endif
        }
        SEAM(P + 1);
        TSTAMP(P + 2);
#ifndef NO_G2
        if (IN(P + 2)) {
            PTRS();
            pg8::Gemm g{YC, (const bf16*)(ws + WS_WBR) + ((size_t)l * 4 + 2) * DM * MIXW, M, 2 * DM, MIXW}; pg8::StaticOrder S; S.init(M, 2 * DM, G, bx);
            pg8::EpiGlu E{PROJ, PB};
            pg8::gemm_phase<pg8::EpiGlu, pg8::StaticOrder, true, true>((LAS unsigned char*)lds + RING_OFF, g, S, E);
        }
#endif
        GSEAM(P + 2, 0);
        TSTAMP(P + 3);
#ifndef NO_G2
        if (IN(P + 3)) {
            PTRS();
            const bf16* WB = (const bf16*)(ws + WS_WBR) + (size_t)l * 4 * DM * MIXW;
            pg8::StaticOrder S; S.init(M, DM, G, bx);
            { pg8::Gemm g{YA, WB + 0 * (size_t)DM * MIXW, M, DM, MIXW}; pg8::EpiBrAcc E{PROJ, PB, 0}; pg8::gemm_phase<pg8::EpiBrAcc, pg8::StaticOrder, true, true>((LAS unsigned char*)lds + RING_OFF, g, S, E); }
            { pg8::Gemm g{YB, WB + 1 * (size_t)DM * MIXW, M, DM, MIXW}; pg8::EpiBrAcc E{PROJ, PB, 1}; pg8::gemm_phase<pg8::EpiBrAcc, pg8::StaticOrder, true, true>((LAS unsigned char*)lds + RING_OFF, g, S, E); }
        }
#endif
        GSEAM(P + 3, 1);
        TSTAMP(P + 4);
#ifndef NO_G3
        if (IN(P + 4)) {
            PTRS();
            pg8::Gemm g{PB, (const bf16*)(ws + WS_WOUT) + (size_t)l * DM * DM, M, DM, DM}; pg8::StaticOrder S; S.init(M, DM, G, bx);
            for (int rep_ = 1; rep_ < REP_G3; ++rep_) { pg8::EpiRes E2{l == 0 ? x_in : (const float*)X, (float*)PROJ, YA, (float*)YB}; pg8::gemm_phase<pg8::EpiRes, pg8::StaticOrder, ALIGN_RES, true>((LAS unsigned char*)lds + RING_OFF, g, S, E2); }
            pg8::EpiRes E{l == 0 ? x_in : (const float*)X, X, Hn, PART};
            pg8::gemm_phase<pg8::EpiRes, pg8::StaticOrder, ALIGN_RES, true>((LAS unsigned char*)lds + RING_OFF, g, S, E);
        }
#endif
        GSEAM(P + 4, 2);
        TSTAMP(P + 6);
#ifndef NO_G5
#ifdef DBG_CLK
        if (l == 1 && bx == 0 && tid == 0) { const unsigned long long c_ = clock64(), r_ = wall_clock64(); MISC[16] = (unsigned)c_; MISC[17] = (unsigned)(c_ >> 32); MISC[18] = (unsigned)r_; MISC[19] = (unsigned)(r_ >> 32); }
#endif
        if (IN(P + 6)) for (int rep_ = 0; rep_ < REP_G5; ++rep_) {
            PTRS();
            pg8::Gemm g{Hn, (const bf16*)(ws + WS_WGU) + (size_t)l * 2 * FFH * DM, M, 2 * FFH, DM}; pg8::StaticOrder S; S.init(M, 2 * FFH, G, bx);
            RINV_PASS();
            pg8::EpiSwiglu E{HID, RINV};
            pg8::gemm_phase<pg8::EpiSwiglu, pg8::StaticOrder, true, true>((LAS unsigned char*)lds + RING_OFF, g, S, E);
        }
#endif
#ifdef DBG_CLK
        if (l == 1 && bx == 0 && tid == 0) { const unsigned long long ck0 = ((unsigned long long)MISC[17] << 32) | MISC[16], rt0 = ((unsigned long long)MISC[19] << 32) | MISC[18];
            const unsigned long long dck = clock64() - ck0, drt = wall_clock64() - rt0;
            MISC[20] = (unsigned)(dck * 100ull / (drt ? drt : 1ull)); }
#endif
        GSEAM(P + 6, 3);
        TSTAMP(P + 7);
#ifndef NO_G6
        if (IN(P + 7)) {
            PTRS();
            pg8::Gemm g{HID, (const bf16*)(ws + WS_WDN) + (size_t)l * DM * FFH, M, DM, FFH}; pg8::StaticOrder S; S.init(M, DM, G, bx);
            for (int rep_ = 1; rep_ < REP_G6; ++rep_) { pg8::EpiRes E2{X, (float*)PB, YA, (float*)YB}; pg8::gemm_phase<pg8::EpiRes, pg8::StaticOrder, ALIGN_RES, true>((LAS unsigned char*)lds + RING_OFF, g, S, E2); }
            pg8::EpiRes E{X, X, Hn, PART};
            pg8::gemm_phase<pg8::EpiRes, pg8::StaticOrder, ALIGN_RES, true>((LAS unsigned char*)lds + RING_OFF, g, S, E);
        }
#endif
        GSEAM(P + 7, 4);
        TSTAMP(P + 8);
        if (IN(P + 8) && l + 1 == DEPTH) {
            PTRS(); LANEW();
            if (OPT_GROUPS && ONE_LAUNCH && G == 256) { const int m0 = 256 * (8 * (bx & 7) + ((bx >> 3) & 7)) + 64 * (bx >> 6) + 8 * wave;
                for (int k = 0; k < 8; ++k) rms_row_f32(X + (size_t)(m0 + k) * DM, PAR + P_GFIN, lane); }
            else { for (int m = gw; m < M; m += NGW) rms_row_f32(X + (size_t)m * DM, PAR + P_GFIN, lane); }
        }
    }
    TSTAMP(N_PHASES);
#ifdef DBG_T_LO
    { int t_ = threadIdx.x; asm volatile("" : "+v"(t_)); if (blockIdx.x == 0 && t_ == 0) { const unsigned long long t0 = wall_clock64(); while (wall_clock64() - t0 < (unsigned long long)MISC[21]) __builtin_amdgcn_s_sleep(8); } }
#endif
#ifdef DBG_CLK
    if (bx == 0 && tid == 0) { const unsigned long long t0 = wall_clock64(); while (wall_clock64() - t0 < (unsigned long long)MISC[20] * 100ull) __builtin_amdgcn_s_sleep(8); }
#endif
#undef IN
#undef SEAM
}

#ifdef DBG_DUMP
__global__ void dbg_dump(const bf16* src, float* out) {
    for (size_t i = (size_t)blockIdx.x * 256 + threadIdx.x; i < (size_t)M * DM; i += (size_t)gridDim.x * 256) { const size_t m = i / DM, c = i % DM; out[i] = bf2f(src[m * DBG_PITCH + (c % DBG_PITCH)]); }
}
#endif
extern "C" void kernel_launch(void* const* d_in, const int* in_sizes, int n_in, void* d_out, int out_size, void* d_ws, size_t ws_size, hipStream_t stream) {
    static int grid = 0;
    if (grid == 0) {
        if (n_in != 28 || in_sizes[0] != M * DM || out_size != M * DM || ws_size < WS_END) {
            fprintf(stderr, "kernel_launch: built for 28 inputs, x/out of %d floats, >= %zu bytes of workspace; got n_in %d, in0 %d, out %d, ws %zu; nothing launched\n", M * DM, (size_t)WS_END, n_in, n_in > 0 ? in_sizes[0] : -1, out_size, ws_size);
            grid = -1; return; }
        int dev = 0, cus = 0, per_cu = 0;
        if (hipGetDevice(&dev) != hipSuccess || hipDeviceGetAttribute(&cus, hipDeviceAttributeMultiprocessorCount, dev) != hipSuccess) { fprintf(stderr, "kernel_launch: device query failed\n"); grid = -1; return; }
        if (hipFuncSetAttribute((const void*)fwd_kernel, hipFuncAttributeMaxDynamicSharedMemorySize, LDS_BYTES) != hipSuccess) { fprintf(stderr, "kernel_launch: hipFuncSetAttribute failed\n"); grid = -1; return; }
        if (hipOccupancyMaxActiveBlocksPerMultiprocessor(&per_cu, (const void*)fwd_kernel, NWAVES * 64, LDS_BYTES) != hipSuccess || per_cu < 1)
            fprintf(stderr, "kernel_launch: note: occupancy query reports %d workgroups per CU\n", per_cu);
        (void)hipGetLastError();
        grid = cus;
        if (grid > 256) grid = 256;
        if (grid != 256) { fprintf(stderr, "kernel_launch: this build maps row panels to workgroups for 256 CUs; found %d; nothing launched\n", cus); grid = -1; return; }
    }
    if (grid < 0) return;
    if (hipMemsetAsync((char*)d_ws + WS_CTL, 0, CTL_ZERO_BYTES, stream) != hipSuccess) { fprintf(stderr, "kernel_launch: memset failed\n"); return; }
    Args a{};
    for (int i = 0; i < 28; ++i) a.in[i] = (const float*)d_in[i];
    a.out = (float*)d_out; a.ws = (unsigned char*)d_ws;
    if (ONE_LAUNCH) {
        a.ph_lo = 0; a.ph_hi = N_PHASES;
        hipLaunchKernelGGL(fwd_kernel, dim3(grid), dim3(NWAVES * 64), LDS_BYTES, stream, a);
    } else {
#ifdef DBG_STOP
        for (int p = 0; p < DBG_STOP; ++p) { a.ph_lo = p;
#else
        for (int p = 0; p < N_PHASES; ++p) { a.ph_lo = p;
#endif
         a.ph_hi = p + 1; hipLaunchKernelGGL(fwd_kernel, dim3(grid), dim3(NWAVES * 64), LDS_BYTES, stream, a); }
#ifdef DBG_DUMP
        hipLaunchKernelGGL(dbg_dump, dim3(1024), dim3(256), 0, stream, (const bf16*)((unsigned char*)d_ws + DBG_DUMP), (float*)d_out);
#endif
    }
    const hipError_t le = hipPeekAtLastError();
    if (le != hipSuccess) fprintf(stderr, "kernel_launch: launch failed: %s\n", hipGetErrorName(le));
}
```

```cpp
#include <hip/hip_runtime.h>
#include <cstdio>
#include <cstdint>
namespace pg8 {
#define PG8_LAS __attribute__((address_space(3)))
typedef unsigned short bf16_t;
typedef short bf16x8 __attribute__((ext_vector_type(8)));
typedef float f32x4 __attribute__((ext_vector_type(4)));
typedef unsigned u32x4 __attribute__((ext_vector_type(4)));
typedef unsigned u32x2 __attribute__((ext_vector_type(2)));
constexpr int BM = 256, BK = 64, HALF = 128, HTB = HALF * BK * 2  , STAGE_BYTES = 8 * HTB, NXCD = 8, WGM = 8;

__host__ __device__ __forceinline__ int lds_byte(int r, int c) { const int st = (r >> 4) * 2 + (c >> 5), rr = r & 15, cc = c & 31, ob = rr * 64 + cc * 2; return st * 1024 + (ob ^ (((ob >> 9) & 1) << 5)); }
__host__ __device__ __forceinline__ void stage_rc(int b, int& R, int& C) { const int st = b / 1024, sb = b % 1024, swz = sb ^ (((sb >> 9) & 1) << 5); R = (st >> 1) * 16 + swz / 64; C = (st & 1) * 32 + (swz % 64) / 2; }
__host__ __device__ __forceinline__ int perm32(int rho) { const int n = rho >> 4, i = rho & 15; return 8 * (i >> 2) + 4 * n + (i & 3); }

struct Unit { int pm, pn; };
struct Gemm { const bf16_t* A; const bf16_t* Bt; int M, N, K; };

struct StaticOrder {
    int nM, nN, nwg, G, c, rev;
    __host__ __device__ void init(int M, int N, int G_, int c_) { nM = M / BM; nN = N / BM; nwg = nM * nN; G = G_; c = c_; rev = 0; }
    __host__ __device__ bool next(int i, Unit& u) const {
        if (rev) { const int nr = (nwg - c + G - 1) / G; if (i >= nr) return false; i = nr - 1 - i; }
        const long L = (long)i * G + c; if (L >= nwg) return false;
        int wgid = (int)L; { const int q = nwg / NXCD, r = nwg % NXCD, xcd = wgid % NXCD, off = wgid / NXCD; wgid = (xcd < r ? xcd * (q + 1) : r * (q + 1) + (xcd - r) * q) + off; }
        const int nig = WGM * nN, gid = wgid / nig, fm = gid * WGM, gsz = (nM - fm) < WGM ? (nM - fm) : WGM;
        u.pm = fm + ((wgid % nig) % gsz); u.pn = (wgid % nig) / gsz; return true;
    }
    __device__ __forceinline__ void a_ready(const Unit&) const {}
    __device__ __forceinline__ void done(const Unit&) const {}
};

__device__ __forceinline__ unsigned cvt_pk_bf16(float lo, float hi) { typedef __bf16 bf2_ __attribute__((ext_vector_type(2))); typedef float f2_ __attribute__((ext_vector_type(2))); const f2_ v_ = {lo, hi}; const bf2_ r_ = __builtin_convertvector(v_, bf2_); return __builtin_bit_cast(unsigned, r_); }
__device__ __forceinline__ float ex2(float x) { return __builtin_amdgcn_exp2f(x); }
__device__ __forceinline__ float rcp(float x) { return __builtin_amdgcn_rcpf(x); }
__device__ __forceinline__ float sigmoidf_(float x) { return rcp(1.0f + ex2(-1.4426950408889634f * x)); }
__device__ __forceinline__ float gelu_tanh(float x) { const float u = x * (1.0f + 0.044715f * x * x); return x * rcp(1.0f + ex2(-2.302208198f * u)); }
__device__ __forceinline__ float silu_(float x) { return x * sigmoidf_(x); }
__device__ __forceinline__ float bf_lo(unsigned w) { return __uint_as_float(w << 16); }
__device__ __forceinline__ float bf_hi(unsigned w) { return __uint_as_float(w & 0xffff0000u); }

constexpr int LDP = 12288 + 64;
constexpr int GATE_COL = 6144;
constexpr float QSCALE = 0.12751743082459868f;

struct EpiIn {
    static constexpr bool PERM = true, AFTER_DRAIN = false, IDEMPOTENT = true;
    bf16_t* O; const float* gbias; const PG8_LAS float* rinv;
    template <int MODE> __device__ __forceinline__ void run(const f32x4 (&acc)[2][2][4][2], const Unit& u, int wr, int wc, int fr, int fq) const {
        const int row0 = u.pm * BM + wr * 64 + fr, col0 = u.pn * BM + wc * 32 + 8 * fq;
        f32x4 bv[2][2];
#pragma unroll
        for (int bj = 0; bj < 2; ++bj)
#pragma unroll
            for (int n = 0; n < 2; ++n) bv[bj][n] = (MODE == 3) ? *(const f32x4*)(gbias + (col0 - GATE_COL) + bj * HALF + 4 * n) : (f32x4){0.f, 0.f, 0.f, 0.f};
#pragma unroll
        for (int ai = 0; ai < 2; ++ai)
#pragma unroll
            for (int m = 0; m < 4; ++m) { bf16_t* rowp = O + (size_t)(row0 + ai * HALF + m * 16) * LDP + col0; const float rs = rinv[wr * 64 + fr + ai * HALF + m * 16];
#pragma unroll
                for (int bj = 0; bj < 2; ++bj) { f32x4 v0 = acc[ai][bj][m][0] * rs, v1 = acc[ai][bj][m][1] * rs;
                    if (MODE == 1) {
#pragma unroll
                        for (int j = 0; j < 4; ++j) { v0[j] = gelu_tanh(v0[j]); v1[j] = gelu_tanh(v1[j]); }
                    } else if (MODE == 2) { v0 = v0 * QSCALE; v1 = v1 * QSCALE; }
                    else if (MODE == 3) { v0 = v0 + bv[bj][0]; v1 = v1 + bv[bj][1];
#pragma unroll
                        for (int j = 0; j < 4; ++j) { v0[j] = sigmoidf_(v0[j]); v1[j] = sigmoidf_(v1[j]); } }
                    u32x4 w; w.x = cvt_pk_bf16(v0[0], v0[1]); w.y = cvt_pk_bf16(v0[2], v0[3]); w.z = cvt_pk_bf16(v1[0], v1[1]); w.w = cvt_pk_bf16(v1[2], v1[3]);
                    *(u32x4*)(rowp + bj * HALF) = w; } }
    }
    __device__ __forceinline__ void operator()(const f32x4 (&acc)[2][2][4][2], const Unit& u, int wr, int wc, int fr, int fq) const {
        const int pn = u.pn;
        if (pn >= 24) run<3>(acc, u, wr, wc, fr, fq);
        else if (pn < 4 || pn >= 12) run<0>(acc, u, wr, wc, fr, fq);
        else if (pn < 8) run<1>(acc, u, wr, wc, fr, fq);
        else run<2>(acc, u, wr, wc, fr, fq);
    }
};

struct EpiNull {
    static constexpr bool PERM = true, AFTER_DRAIN = false, IDEMPOTENT = false;
    __device__ __forceinline__ void operator()(const f32x4 (&acc)[2][2][4][2], const Unit&, int, int, int, int) const {
#pragma unroll
        for (int ai = 0; ai < 2; ++ai)
#pragma unroll
            for (int bj = 0; bj < 2; ++bj)
#pragma unroll
                for (int m = 0; m < 4; ++m) { f32x4 a = acc[ai][bj][m][0], b = acc[ai][bj][m][1]; asm volatile("" :: "v"(a), "v"(b)); }
    }
};

struct EpiGlu {
    static constexpr bool PERM = true, AFTER_DRAIN = false, IDEMPOTENT = true;
    const bf16_t* G; bf16_t* PB;
    __device__ __forceinline__ void operator()(const f32x4 (&acc)[2][2][4][2], const Unit& u, int wr, int wc, int fr, int fq) const {
        const int row0 = u.pm * BM + wr * 64 + fr, col0 = u.pn * HALF + wc * 32 + 8 * fq;
        u32x4 gw[2][4];
#pragma unroll
        for (int ai = 0; ai < 2; ++ai)
#pragma unroll
            for (int m = 0; m < 4; ++m) gw[ai][m] = *(const u32x4*)(G + (size_t)(row0 + ai * HALF + m * 16) * LDP + GATE_COL + 4096 + col0);
#pragma unroll
        for (int ai = 0; ai < 2; ++ai)
#pragma unroll
            for (int m = 0; m < 4; ++m) { float o[8];
#pragma unroll
                for (int j = 0; j < 4; ++j) {
                    o[2 * j] = bf_lo(gw[ai][m][j]) * (acc[ai][0][m][j >> 1][2 * (j & 1)] * sigmoidf_(acc[ai][1][m][j >> 1][2 * (j & 1)]));
                    o[2 * j + 1] = bf_hi(gw[ai][m][j]) * (acc[ai][0][m][j >> 1][2 * (j & 1) + 1] * sigmoidf_(acc[ai][1][m][j >> 1][2 * (j & 1) + 1])); }
                u32x4 w; w.x = cvt_pk_bf16(o[0], o[1]); w.y = cvt_pk_bf16(o[2], o[3]); w.z = cvt_pk_bf16(o[4], o[5]); w.w = cvt_pk_bf16(o[6], o[7]);
                *(u32x4*)(PB + (size_t)(row0 + ai * HALF + m * 16) * 2048 + col0) = w; }
    }
};
struct EpiBrAcc {
    static constexpr bool PERM = true, AFTER_DRAIN = false, IDEMPOTENT = false;
    const bf16_t* G; bf16_t* PB; int gi;
    __device__ __forceinline__ void operator()(const f32x4 (&acc)[2][2][4][2], const Unit& u, int wr, int wc, int fr, int fq) const {
        const int row0 = u.pm * BM + wr * 64 + fr, col0 = u.pn * BM + wc * 32 + 8 * fq;
#pragma unroll
        for (int ai = 0; ai < 2; ++ai)
#pragma unroll
            for (int hb = 0; hb < 2; ++hb) {
                u32x4 gw[2][2], pw[2][2];
#pragma unroll
                for (int mi = 0; mi < 2; ++mi)
#pragma unroll
                    for (int bj = 0; bj < 2; ++bj) { const size_t row = (size_t)(row0 + ai * HALF + (hb * 2 + mi) * 16); const int col = col0 + bj * HALF;
                        gw[mi][bj] = *(const u32x4*)(G + row * LDP + GATE_COL + 2048 * gi + col);
                        pw[mi][bj] = *(const u32x4*)(PB + row * 2048 + col); }
#pragma unroll
                for (int mi = 0; mi < 2; ++mi)
#pragma unroll
                    for (int bj = 0; bj < 2; ++bj) { const int m = hb * 2 + mi; const size_t row = (size_t)(row0 + ai * HALF + m * 16); const int col = col0 + bj * HALF;
                        float o[8];
#pragma unroll
                        for (int j = 0; j < 4; ++j) {
                            o[2 * j] = bf_lo(pw[mi][bj][j]) + bf_lo(gw[mi][bj][j]) * acc[ai][bj][m][j >> 1][2 * (j & 1)];
                            o[2 * j + 1] = bf_hi(pw[mi][bj][j]) + bf_hi(gw[mi][bj][j]) * acc[ai][bj][m][j >> 1][2 * (j & 1) + 1]; }
                        u32x4 w; w.x = cvt_pk_bf16(o[0], o[1]); w.y = cvt_pk_bf16(o[2], o[3]); w.z = cvt_pk_bf16(o[4], o[5]); w.w = cvt_pk_bf16(o[6], o[7]);
                        *(u32x4*)(PB + row * 2048 + col) = w; }
            }
    }
};

struct EpiRes {
    static constexpr bool PERM = false, AFTER_DRAIN = false, IDEMPOTENT = false;
    const float* base; float* out; bf16_t* hx; float* part;
    __device__ __forceinline__ void operator()(const f32x4 (&acc)[2][2][4][2], const Unit& u, int wr, int wc, int fr, int fq) const {
        const int row0 = u.pm * BM + wr * 64 + fr, col0 = u.pn * BM + wc * 32 + 4 * fq;
#pragma unroll
        for (int ai = 0; ai < 2; ++ai) {
            f32x4 bs[4][2][2];
#pragma unroll
            for (int m = 0; m < 4; ++m) { const size_t off = (size_t)(row0 + ai * HALF + m * 16) * 2048 + col0;
#pragma unroll
                for (int bj = 0; bj < 2; ++bj)
#pragma unroll
                    for (int n = 0; n < 2; ++n) bs[m][bj][n] = *(const f32x4*)(base + off + bj * HALF + n * 16); }
#pragma unroll
            for (int m = 0; m < 4; ++m) { const size_t off = (size_t)(row0 + ai * HALF + m * 16) * 2048 + col0; float ss = 0.f;
#pragma unroll
                for (int bj = 0; bj < 2; ++bj) { const f32x4 v0 = bs[m][bj][0] + acc[ai][bj][m][0], v1 = bs[m][bj][1] + acc[ai][bj][m][1];
                    *(f32x4*)(out + off + bj * HALF) = v0; *(f32x4*)(out + off + bj * HALF + 16) = v1;
                    ss += ((v0[0] * v0[0] + v0[1] * v0[1]) + (v0[2] * v0[2] + v0[3] * v0[3])) + ((v1[0] * v1[0] + v1[1] * v1[1]) + (v1[2] * v1[2] + v1[3] * v1[3]));
                    const unsigned a0 = cvt_pk_bf16(v0[0], v0[1]), a1 = cvt_pk_bf16(v0[2], v0[3]), b0 = cvt_pk_bf16(v1[0], v1[1]), b1 = cvt_pk_bf16(v1[2], v1[3]);
                    const auto s0 = __builtin_amdgcn_permlane16_swap(a0, b0, false, false); const auto s1 = __builtin_amdgcn_permlane16_swap(a1, b1, false, false);
                    u32x4 w = {s0[0], s1[0], s0[1], s1[1]};
                    *(u32x4*)(hx + off + bj * HALF + ((fq & 1) ? 12 : 0)) = w; }
                { const unsigned sb_ = __builtin_bit_cast(unsigned, ss); const auto t16 = __builtin_amdgcn_permlane16_swap(sb_, sb_, false, false);
                  ss = __builtin_bit_cast(float, (unsigned)t16[0]) + __builtin_bit_cast(float, (unsigned)t16[1]);
                  const unsigned sc_ = __builtin_bit_cast(unsigned, ss); const auto t32 = __builtin_amdgcn_permlane32_swap(sc_, sc_, false, false);
                  ss = __builtin_bit_cast(float, (unsigned)t32[0]) + __builtin_bit_cast(float, (unsigned)t32[1]); }
                part[((size_t)u.pn * 16384 + (row0 + ai * HALF + m * 16)) * 4 + wc] = ss; }
        }
    }
};

struct EpiSwiglu {
    static constexpr bool PERM = true, AFTER_DRAIN = false, IDEMPOTENT = false;
    bf16_t* Hd; const PG8_LAS float* rinv;
    __device__ __forceinline__ void operator()(const f32x4 (&acc)[2][2][4][2], const Unit& u, int wr, int wc, int fr, int fq) const {
        const int row0 = u.pm * BM + wr * 64 + fr, col0 = u.pn * HALF + wc * 32 + 8 * fq;
#pragma unroll
        for (int ai = 0; ai < 2; ++ai)
#pragma unroll
            for (int m = 0; m < 4; ++m) { bf16_t* rowp = Hd + (size_t)(row0 + ai * HALF + m * 16) * 5632 + col0;
                float o[8]; const float rs = rinv[wr * 64 + fr + ai * HALF + m * 16];
#pragma unroll
                for (int j = 0; j < 4; ++j) { o[j] = silu_(acc[ai][0][m][0][j] * rs) * (acc[ai][1][m][0][j] * rs); o[4 + j] = silu_(acc[ai][0][m][1][j] * rs) * (acc[ai][1][m][1][j] * rs); }
                u32x4 w; w.x = cvt_pk_bf16(o[0], o[1]); w.y = cvt_pk_bf16(o[2], o[3]); w.z = cvt_pk_bf16(o[4], o[5]); w.w = cvt_pk_bf16(o[6], o[7]);
                *(u32x4*)rowp = w; }
    }
};

template <class Epi, class Sched, bool ALIGN_EPI = false, bool SP2 = false>
__device__ __forceinline__ void gemm_phase(PG8_LAS unsigned char* lds, const Gemm g, const Sched& S, const Epi& E) {
    int tid_ = threadIdx.x; asm volatile("" : "+v"(tid_));
    const int tid = tid_, wid = __builtin_amdgcn_readfirstlane(tid >> 6), lane = tid & 63, wr = wid >> 2, wc = wid & 3, fr = lane & 15, fq = lane >> 4;
    const int K = g.K, nt = K / BK;
    unsigned voffA[2], voffB[2];
#pragma unroll
    for (int i = 0; i < 2; ++i) { int R, C; stage_rc(tid * 16 + i * 8192, R, C); const int Rb = Epi::PERM ? ((R & ~31) + perm32(R & 31)) : R;
        voffA[i] = (unsigned)(R * K + C) * 2u; voffB[i] = (unsigned)(Rb * K + C) * 2u; }
    const size_t kstep = (size_t)(BK * 2);
    const size_t hstep = (size_t)HALF * K * 2;
    const size_t tstep = 2 * hstep;
    const unsigned ldsw = (unsigned)wid * 1024u;
    const int aoff = lds_byte(wr * 64 + fr, fq * 8), boff = lds_byte(wc * 32 + fr, fq * 8);
#define PG8_SA(b, h) (((b) * 2 + (h)) * HTB)
#define PG8_SB(b, h) ((4 + (b) * 2 + (h)) * HTB)
#define PG8_STAGE(bufoff, gbase, voff) do { _Pragma("unroll") for (int _i = 0; _i < 2; ++_i) \
        __builtin_amdgcn_global_load_lds((const unsigned*)((const char*)(gbase) + (voff)[_i]), (PG8_LAS unsigned*)(lds + (bufoff) + ldsw + _i * 8192), 16, 0, 0); } while (0)
#define PG8_LDA(dst, b, h) do { _Pragma("unroll") for (int m = 0; m < 4; ++m) _Pragma("unroll") for (int k = 0; k < 2; ++k) dst[m][k] = *(const PG8_LAS bf16x8*)(lds + PG8_SA(b, h) + aoff + m * 2048 + k * 1024); } while (0)
#define PG8_LDB(dst, b, h) do { _Pragma("unroll") for (int n = 0; n < 2; ++n) _Pragma("unroll") for (int k = 0; k < 2; ++k) dst[n][k] = *(const PG8_LAS bf16x8*)(lds + PG8_SB(b, h) + boff + n * 2048 + k * 1024); } while (0)
#define PG8_MMA(ai, bj, At, Bt) do { __builtin_amdgcn_s_setprio(1); _Pragma("unroll") for (int m = 0; m < 4; ++m) _Pragma("unroll") for (int n = 0; n < 2; ++n) _Pragma("unroll") for (int k = 0; k < 2; ++k) \
        acc[ai][bj][m][n] = __builtin_amdgcn_mfma_f32_16x16x32_bf16(Bt[n][k], At[m][k], acc[ai][bj][m][n], 0, 0, 0); __builtin_amdgcn_s_setprio(0); } while (0)
#define PG8_WAIT_V(n) asm volatile("s_waitcnt vmcnt(" #n ")" ::: "memory")
#define PG8_WAIT_L(n) asm volatile("s_waitcnt lgkmcnt(" #n ")" ::: "memory")
#define PG8_BAR __builtin_amdgcn_s_barrier()
#define PG8_SCHED __builtin_amdgcn_sched_barrier(0)
    Unit cur, nxt; int ui = 0;
    if (!S.next(0, cur)) return;
    f32x4 acc[2][2][4][2];
#pragma unroll
    for (int a = 0; a < 2; ++a)
#pragma unroll
        for (int b = 0; b < 2; ++b)
#pragma unroll
            for (int m = 0; m < 4; ++m)
#pragma unroll
                for (int n = 0; n < 2; ++n) acc[a][b][m][n] = (f32x4){0.f, 0.f, 0.f, 0.f};
    bf16x8 At[4][2], B0[2][2], B1[2][2];
    const char* cA = (const char*)g.A + (size_t)cur.pm * tstep; const char* cB = (const char*)g.Bt + (size_t)cur.pn * tstep;
    S.a_ready(cur);
    if constexpr (SP2) {
        PG8_STAGE(PG8_SB(0, 0), cB, voffB); PG8_STAGE(PG8_SB(0, 1), cB + hstep, voffB); PG8_STAGE(PG8_SA(0, 0), cA, voffA); PG8_STAGE(PG8_SA(0, 1), cA + hstep, voffA);
        if (wr == 1) PG8_BAR;
        PG8_WAIT_V(2); PG8_BAR;
        PG8_STAGE(PG8_SB(1, 0), cB + kstep, voffB); PG8_STAGE(PG8_SA(1, 0), cA + kstep, voffA); PG8_STAGE(PG8_SB(1, 1), cB + hstep + kstep, voffB);
        PG8_WAIT_V(6); PG8_BAR;
    } else {
        PG8_STAGE(PG8_SB(0, 0), cB, voffB); PG8_STAGE(PG8_SA(0, 0), cA, voffA); PG8_STAGE(PG8_SB(0, 1), cB + hstep, voffB); PG8_STAGE(PG8_SA(0, 1), cA + hstep, voffA);
        if (wr == 1) PG8_BAR;
        PG8_WAIT_V(4); PG8_BAR;
        PG8_STAGE(PG8_SB(1, 0), cB + kstep, voffB); PG8_STAGE(PG8_SA(1, 0), cA + kstep, voffA); PG8_STAGE(PG8_SB(1, 1), cB + hstep + kstep, voffB);
        PG8_WAIT_V(6); PG8_BAR;
    }
    for (;;) {
        const bool has_next = S.next(ui + 1, nxt);
        const char* nA = has_next ? (const char*)g.A + (size_t)nxt.pm * tstep : cA; const char* nB = has_next ? (const char*)g.Bt + (size_t)nxt.pn * tstep : cB;
        for (int t = 0; t < nt; t += 2) {
            const bool last = (t == nt - 2);
            const char* a1 = cA + (size_t)(t + 1) * kstep;
            const char* a2 = last ? nA : cA + (size_t)(t + 2) * kstep; const char* b2 = last ? nB : cB + (size_t)(t + 2) * kstep;
            const char* a3 = a2 + kstep; const char* b3 = b2 + kstep;
            if (last && has_next) S.a_ready(nxt);
            if constexpr (SP2) {
            PG8_LDB(B0, 0, 0); PG8_LDB(B1, 0, 1); PG8_SCHED; PG8_LDA(At, 0, 0); PG8_STAGE(PG8_SA(1, 1), a1 + hstep, voffA);
            PG8_WAIT_V(8); PG8_WAIT_L(0); PG8_BAR; PG8_MMA(0, 0, At, B0); PG8_MMA(0, 1, At, B1); PG8_BAR; PG8_SCHED;
            PG8_LDA(At, 0, 1); PG8_STAGE(PG8_SB(0, 0), b2, voffB); PG8_STAGE(PG8_SB(0, 1), b2 + hstep, voffB); PG8_STAGE(PG8_SA(0, 0), a2, voffA);
            PG8_WAIT_V(8); PG8_WAIT_L(0); PG8_BAR; PG8_MMA(1, 0, At, B0); PG8_MMA(1, 1, At, B1); PG8_BAR; PG8_SCHED;
            PG8_LDB(B0, 1, 0); PG8_LDB(B1, 1, 1); PG8_SCHED; PG8_LDA(At, 1, 0); PG8_STAGE(PG8_SA(0, 1), a2 + hstep, voffA);
            PG8_WAIT_V(8); PG8_WAIT_L(0); PG8_BAR; PG8_MMA(0, 0, At, B0); PG8_MMA(0, 1, At, B1); PG8_BAR; PG8_SCHED;
            PG8_LDA(At, 1, 1); PG8_STAGE(PG8_SB(1, 0), b3, voffB); PG8_STAGE(PG8_SB(1, 1), b3 + hstep, voffB); PG8_STAGE(PG8_SA(1, 0), a3, voffA);
            PG8_WAIT_V(8); PG8_WAIT_L(0); PG8_BAR; PG8_MMA(1, 0, At, B0); PG8_MMA(1, 1, At, B1); PG8_BAR; PG8_SCHED;
            } else {
            PG8_LDB(B0, 0, 0); PG8_SCHED; PG8_LDA(At, 0, 0); PG8_STAGE(PG8_SA(1, 1), a1 + hstep, voffA);
            PG8_WAIT_L(8); PG8_BAR; PG8_WAIT_L(0); PG8_MMA(0, 0, At, B0); PG8_BAR; PG8_SCHED;
            PG8_LDB(B1, 0, 1); PG8_STAGE(PG8_SB(0, 0), b2, voffB);
            PG8_BAR; PG8_WAIT_L(0); PG8_MMA(0, 1, At, B1); PG8_BAR;
            PG8_LDA(At, 0, 1); PG8_STAGE(PG8_SA(0, 0), a2, voffA);
            PG8_BAR; PG8_WAIT_L(0); PG8_MMA(1, 0, At, B0); PG8_BAR; PG8_SCHED;
            PG8_STAGE(PG8_SB(0, 1), b2 + hstep, voffB);
            PG8_WAIT_V(6); PG8_BAR; PG8_MMA(1, 1, At, B1); PG8_BAR;
            PG8_LDB(B0, 1, 0); PG8_SCHED; PG8_LDA(At, 1, 0); PG8_STAGE(PG8_SA(0, 1), a2 + hstep, voffA);
            PG8_WAIT_L(8); PG8_BAR; PG8_WAIT_L(0); PG8_MMA(0, 0, At, B0); PG8_BAR; PG8_SCHED;
            PG8_LDB(B1, 1, 1); PG8_STAGE(PG8_SB(1, 0), b3, voffB);
            PG8_BAR; PG8_WAIT_L(0); PG8_MMA(0, 1, At, B1); PG8_BAR;
            PG8_LDA(At, 1, 1); PG8_STAGE(PG8_SA(1, 0), a3, voffA);
            PG8_BAR; PG8_WAIT_L(0); PG8_MMA(1, 0, At, B0); PG8_BAR; PG8_SCHED;
            PG8_STAGE(PG8_SB(1, 1), b3 + hstep, voffB);
            PG8_WAIT_V(6); PG8_BAR; PG8_MMA(1, 1, At, B1); PG8_BAR;
            }
        }
        if constexpr (ALIGN_EPI) { if (wr == 0) PG8_BAR; }
        if constexpr (!Epi::AFTER_DRAIN) { E(acc, cur, wr, wc, fr, fq); S.done(cur); }
#ifdef OPT_EPI2
        if constexpr (!Epi::AFTER_DRAIN && Epi::IDEMPOTENT) { E(acc, cur, wr, wc, fr, fq); }
#endif
        if (!has_next) break;
#pragma unroll
        for (int a = 0; a < 2; ++a)
#pragma unroll
            for (int b = 0; b < 2; ++b)
#pragma unroll
                for (int m = 0; m < 4; ++m)
#pragma unroll
                    for (int n = 0; n < 2; ++n) acc[a][b][m][n] = (f32x4){0.f, 0.f, 0.f, 0.f};
        cur = nxt; cA = nA; cB = nB; ++ui;
        if constexpr (ALIGN_EPI) { if (wr == 1) PG8_BAR; }
    }
    PG8_WAIT_V(0);
    if constexpr (!ALIGN_EPI) { if (wr == 0) PG8_BAR; }
    PG8_BAR;
    if constexpr (Epi::AFTER_DRAIN) { E.fused(acc, cur, wr, wc, fr, fq, lds, wid, lane); S.done(cur); }
#undef PG8_SA
#undef PG8_SB
#undef PG8_STAGE
#undef PG8_LDA
#undef PG8_LDB
#undef PG8_MMA
#undef PG8_WAIT_V
#undef PG8_WAIT_L
#undef PG8_BAR
#undef PG8_SCHED
}
}
#define GAS __attribute__((address_space(1)))
#define LAS __attribute__((address_space(3)))
typedef unsigned short bf16;
typedef unsigned v4u __attribute__((ext_vector_type(4)));
typedef float f32x4 __attribute__((ext_vector_type(4)));
typedef short bf16x8 __attribute__((ext_vector_type(8)));
typedef GAS unsigned gu32;
typedef GAS unsigned long long gu64;
#define RLX_AGENT __ATOMIC_RELAXED, __HIP_MEMORY_SCOPE_AGENT
#define LDS_WAIT() asm volatile("s_waitcnt lgkmcnt(0)" ::: "memory")
#define VM_WAIT() asm volatile("s_waitcnt vmcnt(0)" ::: "memory")
__device__ __forceinline__ unsigned long long rt() { return __builtin_amdgcn_s_memrealtime(); }
__device__ __forceinline__ unsigned f2bf(float f) { unsigned u = __builtin_bit_cast(unsigned, f); return (u + 0x7fffu + ((u >> 16) & 1u)) >> 16; }
__device__ __forceinline__ unsigned pk2(float lo, float hi) { return f2bf(lo) | (f2bf(hi) << 16); }

#define XB_TMO      128
#define XB_XCNT(j)  (256  + 64 * (j))
#define XB_XSUB(j)  (1280 + 64 * (j))
#define XB_XGEN(j)  (2304 + 64 * (j))
#define XB_TOP      3328
#define XB_TOPGEN   3392
#define XCD_BAR_WORDS 3456
#define XB_SPIN_CAP (1u << 18)

__device__ __forceinline__ unsigned xb_ld(unsigned* p)              { return __hip_atomic_load(p, __ATOMIC_RELAXED, __HIP_MEMORY_SCOPE_AGENT); }
__device__ __forceinline__ unsigned xb_add(unsigned* p, unsigned v) { return __hip_atomic_fetch_add(p, v, __ATOMIC_RELAXED, __HIP_MEMORY_SCOPE_AGENT); }
__device__ __forceinline__ unsigned xb_xcc_id() { return (unsigned)__builtin_amdgcn_s_getreg((3 << 11) | 20) & 0xFu; }
#define XB_SPIN(cond, bar) do { unsigned _sp = 0; while (cond) { __builtin_amdgcn_s_sleep(1); \
    if ((++_sp & 255u) == 0u) { if (xb_ld(&(bar)[XB_TMO])) break; if (_sp > XB_SPIN_CAP) { atomicAdd(&(bar)[XB_TMO], 1u); break; } } } } while (0)

struct XcdBarrier {
    unsigned* bar; unsigned x;
    volatile LAS unsigned* st;
};

__device__ __forceinline__ XcdBarrier xcd_barrier_post(unsigned* bar, volatile LAS unsigned* st) {
    XcdBarrier b; b.bar = bar; b.x = xb_xcc_id(); b.st = st;
    if (threadIdx.x == 0) (void)xb_add(&bar[XB_XCNT(b.x)], 1u);
    return b;
}
__device__ __forceinline__ void xcd_barrier_complete(unsigned* bar, unsigned x, unsigned& nloc, unsigned& nx) {
    const unsigned G = gridDim.x * gridDim.y * gridDim.z;
    unsigned sum, cnt, mine, sp = 0u;
    for (;;) {
        sum = 0u; cnt = 0u; mine = 0u;
#pragma unroll
        for (unsigned j = 0; j < 16; ++j) { const unsigned c = xb_ld(&bar[XB_XCNT(j)]); sum += c; cnt += (c > 0u) ? 1u : 0u; mine = (j == x) ? c : mine; }
        if (sum == G) break;
        __builtin_amdgcn_s_sleep(1);
        if ((++sp & 255u) == 0u) { if (xb_ld(&bar[XB_TMO])) break; if (sp > XB_SPIN_CAP) { atomicAdd(&bar[XB_TMO], 1u); break; } }
    }
    nloc = mine > 0u ? mine : 1u; nx = cnt > 0u ? cnt : 1u;
}

__device__ __forceinline__ void xcd_barrier(const XcdBarrier& b) {
    asm volatile("s_waitcnt vmcnt(0)" ::: "memory");
    __syncthreads();
    if (threadIdx.x == 0) {
        unsigned* bar = b.bar;
        __builtin_amdgcn_s_waitcnt(0);
        unsigned nloc = b.st[0], nx = b.st[1];
        if (nloc == 0u) { xcd_barrier_complete(bar, b.x, nloc, nx); b.st[0] = nloc; b.st[1] = nx; }
        const unsigned old = xb_add(&bar[XB_XSUB(b.x)], 1u);
        const unsigned gen = old / nloc;
        if (old + 1u == (gen + 1u) * nloc) {
            __builtin_amdgcn_fence(__ATOMIC_RELEASE, "agent");
            asm volatile("s_waitcnt vmcnt(0)" ::: "memory");
            const unsigned og = xb_add(&bar[XB_TOP], 1u);
            const unsigned tg = og / nx;
            if (og + 1u == (tg + 1u) * nx) xb_add(&bar[XB_TOPGEN], 1u);
            else XB_SPIN(xb_ld(&bar[XB_TOPGEN]) == tg, bar);
            __builtin_amdgcn_fence(__ATOMIC_ACQUIRE, "agent");
            xb_add(&bar[XB_XGEN(b.x)], 1u);
            asm volatile("s_waitcnt vmcnt(0)" ::: "memory");
        } else {
            XB_SPIN(xb_ld(&bar[XB_XGEN(b.x)]) == gen, bar);
            __builtin_amdgcn_fence(__ATOMIC_ACQUIRE, "agent");
            asm volatile("s_waitcnt vmcnt(0)" ::: "memory");
        }
    }
    __syncthreads();
}

constexpr int NWAVES = 8;
constexpr int BATCH = 4, SEQ = 4096, DM = 2048, DEPTH = 4, MIXW = 1024, INW = 12288, FFH = 5632;
constexpr int M = BATCH * SEQ;
constexpr int LDP = pg8::LDP;
constexpr int COL_LX = 0, COL_LG = 1024, COL_Q = 2048, COL_K = 3072, COL_V = 4096, COL_U = 5120, COL_G = 6144;
constexpr float NORM_EPS = 1e-6f;
constexpr float LOG2E = 1.4426950408889634f;

constexpr size_t MiB = 1u << 20;
constexpr size_t WS_CTL = 0, CTL_ZERO_BYTES = 1 * MiB;
constexpr size_t WS_PAR = 1 * MiB;
constexpr size_t WS_WIN = 9 * MiB;
constexpr size_t WS_WBR = WS_WIN + 192 * MiB;
constexpr size_t WS_WOUT = WS_WBR + 64 * MiB;
constexpr size_t WS_WGU = WS_WOUT + 32 * MiB;
constexpr size_t WS_WDN = WS_WGU + 176 * MiB;
constexpr size_t WS_H = WS_WDN + 88 * MiB;
constexpr size_t WS_PROJ = WS_H + 64 * MiB;
constexpr size_t WS_YA = WS_PROJ + 388 * MiB, WS_YB = WS_YA + 32 * MiB, WS_YC = WS_YB + 32 * MiB;
constexpr size_t WS_PB = WS_YC + 32 * MiB, WS_SB = WS_PB + 64 * MiB;
constexpr size_t WS_HID = WS_SB + 64 * MiB;
constexpr size_t WS_END = WS_HID + 176 * MiB;
constexpr int P_GMIX = 0, P_GBIAS = 2048, P_CONVW = 8192, P_CONVB = 12288, P_BA = 13312, P_BX = 14336, P_LAM = 15360, P_RELB = 16384, P_ARE = 18688, P_AIM = 22784, P_D = 26880, P_LOGSTEP = 27904,
              P_GFFN = 28160, P_WA = 30208, P_WX = 95744, P_BRE = 161280, P_BIM = 226816, P_CRE = 292352, P_CIM = 357888, P_GFIN = 423424, PAR_STRIDE = 425984;
static_assert((size_t)DEPTH * PAR_STRIDE * 4 <= 8 * MiB, "PAR");
constexpr int CW_BAR = 4096;
constexpr int CW_GRPX = 16384;
constexpr int CW_GRP = 8192;
static_assert(CW_BAR + XCD_BAR_WORDS <= CW_GRP && (CW_GRP + 64 * 64) <= CW_GRPX && (CW_GRPX + 256) * 4 <= (int)CTL_ZERO_BYTES, "CTL");

constexpr int RING_OFF = 0, RING_BYTES = 131072;
constexpr int LDSCTL_OFF = RING_BYTES, MISC_OFF = LDSCTL_OFF + 320, RINV_OFF = LDSCTL_OFF + 1024;
constexpr int LDS_BYTES = 147456;

typedef float f32x16 __attribute__((ext_vector_type(16)));
typedef short s16x4 __attribute__((ext_vector_type(4)));
typedef unsigned u32x2 __attribute__((ext_vector_type(2)));
using pg8::ex2; using pg8::rcp;

__device__ __forceinline__ float wave_sum(float v) {
#pragma unroll
    for (int o = 1; o < 64; o <<= 1) v += __shfl_xor(v, o);
    return v;
}
__device__ __forceinline__ unsigned cvtpk(float lo, float hi) { typedef __bf16 bf2_ __attribute__((ext_vector_type(2))); typedef float f2_ __attribute__((ext_vector_type(2))); const f2_ v_ = {lo, hi}; const bf2_ r_ = __builtin_convertvector(v_, bf2_); return __builtin_bit_cast(unsigned, r_); }
__device__ __forceinline__ float bf2f(bf16 v) { return __uint_as_float(((unsigned)v) << 16); }
__device__ __forceinline__ bf16 f2bf16(float f) { return (bf16)(cvtpk(f, 0.f) & 0xffffu); }

template <class F>
__device__ __forceinline__ void transpose_item(const float* W, int K, int N, bf16* WT, F drow, LAS float* scr, int item, int lane, const float* ksc = nullptr  ) {
    const int nblk = N / 32, kb = item / nblk, nb = item % nblk, k0 = 64 * kb, n0 = 32 * nb;
#pragma unroll 8
    for (int i = 0; i < 32; ++i) { const int kk = 2 * i + (lane >> 5); scr[kk * 33 + (lane & 31)] = W[(size_t)(k0 + kk) * N + n0 + (lane & 31)]; }
    LDS_WAIT(); asm volatile("" ::: "memory");
    const int c = lane & 7;
    const int r0 = drow(n0);
    f32x4 sa = {1.f, 1.f, 1.f, 1.f}, sb = sa;
    if (ksc) { sa = *(const GAS f32x4*)(ksc + k0 + 8 * c); sb = *(const GAS f32x4*)(ksc + k0 + 8 * c + 4); }
#pragma unroll
    for (int j = 0; j < 4; ++j) { const int n = (lane >> 3) + 8 * j; const LAS float* s = scr + (8 * c) * 33 + n;
        v4u o; o.x = cvtpk(s[0 * 33] * sa.x, s[1 * 33] * sa.y); o.y = cvtpk(s[2 * 33] * sa.z, s[3 * 33] * sa.w); o.z = cvtpk(s[4 * 33] * sb.x, s[5 * 33] * sb.y); o.w = cvtpk(s[6 * 33] * sb.z, s[7 * 33] * sb.w);
        *(GAS v4u*)(WT + (size_t)(r0 + n) * K + k0 + 8 * c) = o; }
    LDS_WAIT(); asm volatile("" ::: "memory");
}
struct RowId { __device__ __forceinline__ int operator()(int n) const { return n; } };
struct RowGU { int half; __device__ __forceinline__ int operator()(int n) const { return 256 * (n >> 7) + 128 * half + (n & 127); } };

__device__ __forceinline__ void rms_row_bf16(const float* xrow, const float* g, bf16* orow, int lane) {
    const GAS f32x4* xr = (const GAS f32x4*)xrow + lane; const GAS f32x4* gr = (const GAS f32x4*)g + lane;
    f32x4 v[8]; float s = 0.f;
#pragma unroll
    for (int j = 0; j < 8; ++j) { v[j] = xr[64 * j]; s += (v[j].x * v[j].x + v[j].y * v[j].y) + (v[j].z * v[j].z + v[j].w * v[j].w); }
    const float r = 1.0f / sqrtf(wave_sum(s) * (1.0f / DM) + NORM_EPS);
    GAS u32x2* o8 = (GAS u32x2*)orow + lane;
#pragma unroll
    for (int j = 0; j < 8; ++j) { const f32x4 gg = gr[64 * j]; u32x2 w; w.x = cvtpk(v[j].x * r * gg.x, v[j].y * r * gg.y); w.y = cvtpk(v[j].z * r * gg.z, v[j].w * r * gg.w); o8[64 * j] = w; }
}
__device__ __forceinline__ void row_bf16_ss(const float* xrow, bf16* orow, float* part, int m, int lane);
__device__ __forceinline__ void rms_row_f32(float* xrow, const float* g, int lane) {
    GAS f32x4* xr = (GAS f32x4*)xrow + lane; const GAS f32x4* gr = (const GAS f32x4*)g + lane;
    f32x4 v[8]; float s = 0.f;
#pragma unroll
    for (int j = 0; j < 8; ++j) { v[j] = xr[64 * j]; s += (v[j].x * v[j].x + v[j].y * v[j].y) + (v[j].z * v[j].z + v[j].w * v[j].w); }
    const float r = 1.0f / sqrtf(wave_sum(s) * (1.0f / DM) + NORM_EPS);
#pragma unroll
    for (int j = 0; j < 8; ++j) { const f32x4 gg = gr[64 * j]; xr[64 * j] = (v[j] * r) * gg; }
}

namespace att {
constexpr size_t SHM_V = 64 * 128 * 2, SHM_K = 64 * 128 * 2;
constexpr int OFF_WS = 2 * SHM_V + 2 * SHM_K, OFF_BT = OFF_WS + NWAVES * 64 * 4, ATT_LDS = OFF_BT + 320 * 4;
#define KSWZ(row, colB) ((row) * 256 + ((colB) ^ (((row) & 7) << 4)))
#define SBAR() __builtin_amdgcn_sched_barrier(0)
__device__ __forceinline__ int crow(int r, int hi) { return (r & 3) + 8 * (r >> 2) + 4 * hi; }
__device__ __forceinline__ void qkt(f32x16& p0, f32x16& p1, const char* Ks, const bf16x8* qr, int r32, int hi) {
    p0 = f32x16{}; p1 = f32x16{};
#pragma unroll
    for (int d0 = 0; d0 < 8; ++d0) { const int cb = (d0 * 16 + hi * 8) * 2;
        const bf16x8 b0 = *reinterpret_cast<const bf16x8*>(Ks + KSWZ(r32, cb));
        const bf16x8 b1 = *reinterpret_cast<const bf16x8*>(Ks + KSWZ(32 + r32, cb));
        p0 = __builtin_amdgcn_mfma_f32_32x32x16_bf16(b0, qr[d0], p0, 0, 0, 0);
        p1 = __builtin_amdgcn_mfma_f32_32x32x16_bf16(b1, qr[d0], p1, 0, 0, 0); }
}
__device__ __forceinline__ int v_st(int k, int c) { const int kk = (k & ~0xC) | ((k & 4) << 1) | ((k & 8) >> 1); return ((kk >> 3) * 4 + (c >> 5)) * 512 + ((kk & 7) * 32 + (c & 31)) * 2; }
__device__ __forceinline__ int v_rd_base(int lane) { return ((lane & 3) << 3) | (((lane >> 2) & 3) << 6) | (((lane >> 4) & 1) << 5) | (((lane >> 5) & 1) << 8); }
constexpr int v_rd_off(int d0, int ks, int half) { return d0 * 512 + ks * 4096 + half * 2048; }
template <int OFF> __device__ __forceinline__ s16x4 tr_read(int vb) {
    s16x4 r; asm volatile("ds_read_b64_tr_b16 %0, %1 offset:%2" : "=&v"(r) : "v"(vb), "i"(OFF) : "memory"); return r;
}
template <int D0> __device__ __forceinline__ void pv_one(f32x16& od, int vb, bf16x8 pa0, bf16x8 pa1, bf16x8 pa2, bf16x8 pa3) {
    const s16x4 l0 = tr_read<v_rd_off(D0, 0, 0)>(vb), h0 = tr_read<v_rd_off(D0, 0, 1)>(vb), l1 = tr_read<v_rd_off(D0, 1, 0)>(vb), h1 = tr_read<v_rd_off(D0, 1, 1)>(vb);
    const s16x4 l2 = tr_read<v_rd_off(D0, 2, 0)>(vb), h2 = tr_read<v_rd_off(D0, 2, 1)>(vb), l3 = tr_read<v_rd_off(D0, 3, 0)>(vb), h3 = tr_read<v_rd_off(D0, 3, 1)>(vb);
    asm volatile("s_waitcnt lgkmcnt(0)" ::: "memory"); SBAR();
#define PK(L, H) (bf16x8){L[0], L[1], L[2], L[3], H[0], H[1], H[2], H[3]}
    od = __builtin_amdgcn_mfma_f32_32x32x16_bf16(pa0, PK(l0, h0), od, 0, 0, 0);
    od = __builtin_amdgcn_mfma_f32_32x32x16_bf16(pa1, PK(l1, h1), od, 0, 0, 0);
    od = __builtin_amdgcn_mfma_f32_32x32x16_bf16(pa2, PK(l2, h2), od, 0, 0, 0);
    od = __builtin_amdgcn_mfma_f32_32x32x16_bf16(pa3, PK(l3, h3), od, 0, 0, 0);
#undef PK
}
__device__ __forceinline__ void tile_compute(f32x16 (&o)[4], float& m_reg, float& l_reg, const bf16x8 (&qr)[8], const char* Kbuf, int vb, const LAS float* bt, LAS float* al_l,
                                             int dc  , int qi  , int r32, int hi) {
    f32x16 p0, p1;
    qkt(p0, p1, Kbuf, qr, r32, hi);
    float bcv = 0.f;
    if (dc >= 3) bcv = bt[256];
    else { const LAS float* bp = bt + (64 * dc + qi + 128 - 4 * hi - 59);
#pragma unroll
        for (int r = 0; r < 16; ++r) p0[r] += bp[59 - ((r & 3) + 8 * (r >> 2))];
        SBAR();
#pragma unroll
        for (int r = 0; r < 16; ++r) p1[r] += bp[27 - ((r & 3) + 8 * (r >> 2))];
        SBAR(); }
    float pmax = p0[0];
#pragma unroll
    for (int r = 1; r < 16; ++r) pmax = fmaxf(pmax, p0[r]);
#pragma unroll
    for (int r = 0; r < 16; ++r) pmax = fmaxf(pmax, p1[r]);
    pmax = fmaxf(pmax, __shfl_xor(pmax, 32)) + bcv;
    const float mn = (pmax > m_reg + 8.0f) ? pmax : m_reg, alpha = ex2(m_reg - mn); m_reg = mn;
    const float mnb = mn - bcv;
    typedef float f2_ __attribute__((ext_vector_type(2)));
    const f2_ m2 = {mnb, mnb}; f2_ ps2 = {0.f, 0.f};
#pragma unroll
    for (int r = 0; r < 16; r += 2) {
        const f2_ a = (f2_){p0[r], p0[r + 1]} - m2, b = (f2_){p1[r], p1[r + 1]} - m2;
        p0[r] = ex2(a.x); p0[r + 1] = ex2(a.y); p1[r] = ex2(b.x); p1[r + 1] = ex2(b.y);
        ps2 += (f2_){p0[r], p0[r + 1]}; ps2 += (f2_){p1[r], p1[r + 1]}; }
    float ps = ps2.x + ps2.y;
    ps += __shfl_xor(ps, 32);
    l_reg = l_reg * alpha + ps;
    if (__any(alpha < 1.f)) { if (hi == 0) al_l[r32] = alpha; asm volatile("s_waitcnt lgkmcnt(0)" ::: "memory");
#pragma unroll
        for (int r = 0; r < 16; ++r) { const float a = al_l[crow(r, hi)];
#pragma unroll
            for (int d = 0; d < 4; ++d) o[d][r] *= a; }
        asm volatile("s_waitcnt lgkmcnt(0)" ::: "memory"); }
    bf16x8 pa0, pa1, pa2, pa3;
#define PK4(P, BASE, OUT) do { unsigned a0 = cvtpk(P[BASE + 0], P[BASE + 1]), a1 = cvtpk(P[BASE + 2], P[BASE + 3]);   \
    unsigned b0 = cvtpk(P[BASE + 4], P[BASE + 5]), b1 = cvtpk(P[BASE + 6], P[BASE + 7]);                              \
    auto r0 = __builtin_amdgcn_permlane32_swap(a0, b0, false, false); auto r1 = __builtin_amdgcn_permlane32_swap(a1, b1, false, false); \
    v4u w = {r0[0], r1[0], r0[1], r1[1]}; OUT = *reinterpret_cast<bf16x8*>(&w); } while (0)
    PK4(p0, 0, pa0); PK4(p0, 8, pa1); PK4(p1, 0, pa2); PK4(p1, 8, pa3);
#undef PK4
    pv_one<0>(o[0], vb, pa0, pa1, pa2, pa3); pv_one<1>(o[1], vb, pa0, pa1, pa2, pa3); pv_one<2>(o[2], vb, pa0, pa1, pa2, pa3); pv_one<3>(o[3], vb, pa0, pa1, pa2, pa3);
}

__device__ __forceinline__ void attn_unit(int b, int h, int qb, const bf16* __restrict__ proj, bf16* __restrict__ yb, const float* __restrict__ relb  , char* lds) {
    int tid_ = threadIdx.x; asm volatile("" : "+v"(tid_));
    const int tid = tid_, wid = tid >> 6, lane = tid & 63, r32 = lane & 31, hi = lane >> 5;
    char* V_lds = lds; char* K_lds = lds + 2 * SHM_V;
    LAS float* wsw = (LAS float*)(lds + OFF_WS) + wid * 64; LAS float* li_l = wsw; LAS float* al_l = wsw + 32;
    LAS float* bt = (LAS float*)(lds + OFF_BT);
    for (int i = tid; i < 320; i += NWAVES * 64) bt[i] = relb[i < 256 ? i : 256] * LOG2E;
    float m_reg = -1e30f, l_reg = 0.f; f32x16 o[4] = {}; bf16x8 qr[8];
    const size_t rowq = (size_t)b * SEQ + (size_t)qb * 256 + wid * 32 + r32;
    const bf16* Qw = proj + rowq * LDP + COL_Q + h * 128 + hi * 8;
#pragma unroll
    for (int d0 = 0; d0 < 8; ++d0) qr[d0] = *reinterpret_cast<const bf16x8*>(Qw + d0 * 16);
    const int cq = 4 * qb + (wid >> 1), qi = 32 * (wid & 1) + r32;
    const int kc_lo = (4 * qb - 8) > 0 ? (4 * qb - 8) : 0, NT = 4 * qb + 4 - kc_lo;
    const int my_lo = (cq - 8) > 0 ? (cq - 8) : 0;
    const int sr = tid >> 4, sc = (tid & 15) * 8, vst0 = v_st(sr, sc), vst1 = v_st(32 + sr, sc);
    const int vb0 = (int)(uintptr_t)V_lds + v_rd_base(lane);
    const bf16* Kg = proj + ((size_t)b * SEQ + sr) * LDP + COL_K + h * 128 + sc;
    const bf16* Vg = proj + ((size_t)b * SEQ + sr) * LDP + COL_V + h * 128 + sc;
    bf16x8 eV0, eV1, eK0, eK1, oV0, oV1, oK0, oK1;
#define SLOAD_E(kc) do { const size_t ro = (size_t)(kc) * 64 * LDP; eV0 = *(const bf16x8*)(Vg + ro); eV1 = *(const bf16x8*)(Vg + ro + 32 * (size_t)LDP); eK0 = *(const bf16x8*)(Kg + ro); eK1 = *(const bf16x8*)(Kg + ro + 32 * (size_t)LDP); } while (0)
#define SLOAD_O(kc) do { const size_t ro = (size_t)(kc) * 64 * LDP; oV0 = *(const bf16x8*)(Vg + ro); oV1 = *(const bf16x8*)(Vg + ro + 32 * (size_t)LDP); oK0 = *(const bf16x8*)(Kg + ro); oK1 = *(const bf16x8*)(Kg + ro + 32 * (size_t)LDP); } while (0)
#define SWRITE(bufi, v0, v1, k0, k1) do { *(bf16x8*)(V_lds + (bufi) * SHM_V + vst0) = v0; *(bf16x8*)(V_lds + (bufi) * SHM_V + vst1) = v1; \
    *(bf16x8*)(K_lds + (bufi) * SHM_K + KSWZ(sr, sc * 2)) = k0; *(bf16x8*)(K_lds + (bufi) * SHM_K + KSWZ(32 + sr, sc * 2)) = k1; } while (0)
    SLOAD_E(kc_lo); SWRITE(0, eV0, eV1, eK0, eK1); SLOAD_O(kc_lo + 1); SLOAD_E(kc_lo + 2);
    __syncthreads();
    for (int j = 0; j < NT; j += 2) {
        { const int kc = kc_lo + j; if (kc >= my_lo && kc <= cq) tile_compute(o, m_reg, l_reg, qr, K_lds, vb0, bt, al_l, cq - kc, qi, r32, hi); }
        SWRITE(1, oV0, oV1, oK0, oK1); if (j + 3 < NT) SLOAD_O(kc_lo + j + 3);
        __syncthreads();
        { const int kc = kc_lo + j + 1; if (kc >= my_lo && kc <= cq) tile_compute(o, m_reg, l_reg, qr, K_lds + SHM_K, vb0 + (int)SHM_V, bt, al_l, cq - kc, qi, r32, hi); }
        if (j + 2 < NT) { SWRITE(0, eV0, eV1, eK0, eK1); if (j + 4 < NT) SLOAD_E(kc_lo + j + 4); }
        __syncthreads();
    }
#undef SLOAD_E
#undef SLOAD_O
#undef SWRITE
    if (hi == 0) li_l[r32] = l_reg; asm volatile("s_waitcnt lgkmcnt(0)" ::: "memory");
    bf16* Ow = yb + ((size_t)b * SEQ + (size_t)qb * 256 + wid * 32) * MIXW + h * 128 + r32;
#pragma unroll
    for (int r = 0; r < 16; ++r) { const int orow = crow(r, hi); const float rl = rcp(li_l[orow]);
#pragma unroll
        for (int d0 = 0; d0 < 4; ++d0) Ow[(size_t)orow * MIXW + d0 * 32] = f2bf16(o[d0][r] * rl); }
    asm volatile("s_waitcnt lgkmcnt(0)" ::: "memory");
}
#undef KSWZ
}

__device__ __forceinline__ void store16_wt(void* p, v4u v) { asm volatile("global_store_dwordx4 %0, %1, off sc1\n\ts_nop 2" :: "v"(p), "v"(v) : "memory"); }

__device__ __forceinline__ void row_bf16_ss(const float* xrow, bf16* orow, float* part, int m, int lane) {
    const GAS f32x4* xr = (const GAS f32x4*)xrow + lane; f32x4 v[8]; float s = 0.f;
#pragma unroll
    for (int j = 0; j < 8; ++j) { v[j] = xr[64 * j]; s += (v[j].x * v[j].x + v[j].y * v[j].y) + (v[j].z * v[j].z + v[j].w * v[j].w); }
    s = wave_sum(s);
    GAS u32x2* o8 = (GAS u32x2*)orow + lane;
#pragma unroll
    for (int j = 0; j < 8; ++j) { u32x2 w; w.x = cvtpk(v[j].x, v[j].y); w.y = cvtpk(v[j].z, v[j].w); o8[64 * j] = w; }
    if (lane < 8) { v4u o = {lane == 0 ? __float_as_uint(s) : 0u, 0u, 0u, 0u}; store16_wt(part + ((size_t)lane * M + m) * 4, o); }
}
namespace s5 {
constexpr int XS_PITCH = 272;
constexpr int OFF_UT = 0, OFF_OT = 2048, OFF_XS = 4096, WAVE_BYTES = OFF_XS + 32 * XS_PITCH;
constexpr int OFF_ECH = NWAVES * WAVE_BYTES;
constexpr int S5_LDS = OFF_ECH + 2 * 8 * 64 * 8;
static_assert(S5_LDS <= RING_BYTES, "S5 LDS");
struct cplx { float r, i; };
__device__ __forceinline__ cplx cmul(cplx a, cplx b) { return cplx{a.r * b.r - a.i * b.i, a.r * b.i + a.i * b.r}; }
__device__ __forceinline__ cplx cfma(cplx a, cplx x, cplx y) { return cplx{a.r * x.r - a.i * x.i + y.r, a.r * x.i + a.i * x.r + y.i}; }
__device__ __forceinline__ cplx csel(bool c, cplx a, cplx b) { return cplx{c ? a.r : b.r, c ? a.i : b.i}; }
__device__ __forceinline__ cplx cxor32(cplx a) { return cplx{__shfl_xor(a.r, 32), __shfl_xor(a.i, 32)}; }

__device__ __forceinline__ void chain(int b, int g, const bf16* __restrict__ proj, bf16* __restrict__ yc,
                                      const float* __restrict__ a_re, const float* __restrict__ a_im, const float* __restrict__ b_re, const float* __restrict__ b_im,
                                      const float* __restrict__ c_re, const float* __restrict__ c_im, const float* __restrict__ dvec, const float* __restrict__ log_step, char* lds) {
    int tid_ = threadIdx.x; asm volatile("" : "+v"(tid_));
    const int tid = tid_, wid = tid >> 6, lane = tid & 63, r32 = lane & 31, hi = lane >> 5, hcol = lane & 15, q4 = lane >> 4;
    const float step = expf(log_step[g]);
    cplx lam[2], l16[2], l64[2]; bf16x8 Bre[2], Bim[2];
#pragma unroll
    for (int pt = 0; pt < 2; ++pt) { const int p = 32 * pt + r32; const float are = a_re[g * 64 + p], aim = a_im[g * 64 + p];
        const float mag = expf(are * step), ang = aim * step; float sn, cs; sincosf(ang, &sn, &cs);
        const float lbr = mag * cs, lbi = mag * sn; lam[pt] = cplx{lbr, lbi};
        cplx t = cmul(lam[pt], lam[pt]); t = cmul(t, t); t = cmul(t, t); t = cmul(t, t); l16[pt] = t; t = cmul(t, t); t = cmul(t, t); l64[pt] = t;
        const float den = are * are + aim * aim, nr = lbr - 1.0f, cre = (nr * are + lbi * aim) / den, cim = (lbi * are - nr * aim) / den;
        const f32x4* br4 = (const f32x4*)(b_re + (size_t)(g * 64 + p) * 16 + 8 * hi); const f32x4* bi4 = (const f32x4*)(b_im + (size_t)(g * 64 + p) * 16 + 8 * hi);
        const f32x4 br0 = br4[0], br1 = br4[1], bi0 = bi4[0], bi1 = bi4[1];
        float vr[8], vi[8];
#pragma unroll
        for (int j = 0; j < 4; ++j) { vr[j] = cre * br0[j] - cim * bi0[j]; vi[j] = cre * bi0[j] + cim * br0[j]; vr[4 + j] = cre * br1[j] - cim * bi1[j]; vi[4 + j] = cre * bi1[j] + cim * br1[j]; }
        v4u wr_ = {cvtpk(vr[0], vr[1]), cvtpk(vr[2], vr[3]), cvtpk(vr[4], vr[5]), cvtpk(vr[6], vr[7])}; Bre[pt] = *reinterpret_cast<bf16x8*>(&wr_);
        v4u wi_ = {cvtpk(vi[0], vi[1]), cvtpk(vi[2], vi[3]), cvtpk(vi[4], vi[5]), cvtpk(vi[6], vi[7])}; Bim[pt] = *reinterpret_cast<bf16x8*>(&wi_); }
    bf16x8 cc[4];
#pragma unroll
    for (int ks = 0; ks < 4; ++ks) { const int p0 = 16 * ks + 4 * q4; const f32x4 cr = *(const f32x4*)(c_re + (size_t)(g * 16 + hcol) * 64 + p0), ci = *(const f32x4*)(c_im + (size_t)(g * 16 + hcol) * 64 + p0);
        v4u w = {cvtpk(cr[0], -ci[0]), cvtpk(cr[1], -ci[1]), cvtpk(cr[2], -ci[2]), cvtpk(cr[3], -ci[3])}; cc[ks] = *reinterpret_cast<bf16x8*>(&w); }
    const float dh = dvec[g * 16 + hcol];
    char* wl = lds + wid * WAVE_BYTES; char* ut = wl + OFF_UT; char* ot = wl + OFF_OT; char* xs = wl + OFF_XS;
    const int tokA = 16 * ((r32 >> 2) & 1) + (r32 & 3) + 4 * (r32 >> 3);
    const bf16* uin = proj + ((size_t)b * SEQ + (lane >> 1)) * LDP + COL_U + 16 * g + 8 * (lane & 1);
    bf16* yout = yc + ((size_t)b * SEQ + (lane >> 1)) * MIXW + 16 * g + 8 * (lane & 1);
    const int tio = (lane >> 1) * 32 + 16 * (lane & 1);
    v4u pf0, pf1;
    { const size_t ro = (size_t)(64 * wid) * LDP; pf0 = *(const v4u*)(uin + ro); pf1 = *(const v4u*)(uin + ro + 32 * (size_t)LDP); }
    cplx Xr[2] = {cplx{0.f, 0.f}, cplx{0.f, 0.f}};
    for (int rd = 0; rd < 8; ++rd) {
        const int t0 = 64 * (8 * rd + wid);
        *(LAS v4u*)(ut + tio) = pf0; *(LAS v4u*)(ut + tio + 1024) = pf1;
        if (rd < 7) { const size_t ro = (size_t)(t0 + 512) * LDP; pf0 = *(const v4u*)(uin + ro); pf1 = *(const v4u*)(uin + ro + 32 * (size_t)LDP); }
        asm volatile("s_waitcnt lgkmcnt(0)" ::: "memory"); __builtin_amdgcn_wave_barrier();
        bf16x8 A[2];
#pragma unroll
        for (int tt = 0; tt < 2; ++tt) A[tt] = *(const LAS bf16x8*)(ut + (32 * tt + tokA) * 32 + 16 * hi);
        cplx E[2][2];
#pragma unroll
        for (int tt = 0; tt < 2; ++tt)
#pragma unroll
            for (int pt = 0; pt < 2; ++pt) {
                const f32x16 ur = __builtin_amdgcn_mfma_f32_32x32x16_bf16(A[tt], Bre[pt], f32x16{}, 0, 0, 0);
                const f32x16 ui = __builtin_amdgcn_mfma_f32_32x32x16_bf16(A[tt], Bim[pt], f32x16{}, 0, 0, 0);
                cplx e = cplx{0.f, 0.f};
#pragma unroll
                for (int r = 0; r < 16; ++r) e = cfma(lam[pt], e, cplx{ur[r], ui[r]});
                E[tt][pt] = e; }
        cplx Sg[4][2];
#pragma unroll
        for (int tt = 0; tt < 2; ++tt)
#pragma unroll
            for (int pt = 0; pt < 2; ++pt) { const cplx other = cxor32(E[tt][pt]); Sg[2 * tt][pt] = csel(hi == 0, E[tt][pt], other); Sg[2 * tt + 1][pt] = csel(hi == 0, other, E[tt][pt]); }
        LAS float* ech = (LAS float*)(lds + OFF_ECH) + (rd & 1) * (8 * 64 * 2);
#pragma unroll
        for (int pt = 0; pt < 2; ++pt) { cplx ec = Sg[0][pt]; ec = cfma(l16[pt], ec, Sg[1][pt]); ec = cfma(l16[pt], ec, Sg[2][pt]); ec = cfma(l16[pt], ec, Sg[3][pt]);
            if (hi == 0) { ech[(wid * 64 + 32 * pt + r32) * 2] = ec.r; ech[(wid * 64 + 32 * pt + r32) * 2 + 1] = ec.i; } }
        __syncthreads();
        cplx xin[2];
#pragma unroll
        for (int pt = 0; pt < 2; ++pt) { cplx x = Xr[pt]; xin[pt] = x;
#pragma unroll
            for (int w = 0; w < 8; ++w) { xin[pt] = csel(w == wid, x, xin[pt]); const cplx e = cplx{ech[(w * 64 + 32 * pt + r32) * 2], ech[(w * 64 + 32 * pt + r32) * 2 + 1]}; x = cfma(l64[pt], x, e); }
            Xr[pt] = x; }
#pragma unroll
        for (int tt = 0; tt < 2; ++tt) {
#pragma unroll
            for (int pt = 0; pt < 2; ++pt) {
                const cplx xb0 = xin[pt], xb1 = cfma(l16[pt], xb0, Sg[0][pt]), xb2 = cfma(l16[pt], xb1, Sg[1][pt]), xb3 = cfma(l16[pt], xb2, Sg[2][pt]);
                cplx x = (tt == 0) ? csel(hi == 0, xb0, xb1) : csel(hi == 0, xb2, xb3);
                bf16x8 a2 = A[tt]; asm volatile("" : "+v"(a2));
                const f32x16 ur = __builtin_amdgcn_mfma_f32_32x32x16_bf16(a2, Bre[pt], f32x16{}, 0, 0, 0);
                const f32x16 ui = __builtin_amdgcn_mfma_f32_32x32x16_bf16(a2, Bim[pt], f32x16{}, 0, 0, 0);
#pragma unroll
                for (int r = 0; r < 16; ++r) { x = cfma(lam[pt], x, cplx{ur[r], ui[r]});
                    *(LAS unsigned*)(xs + (16 * hi + r) * XS_PITCH + 4 * (32 * pt + r32)) = cvtpk(x.r, x.i); }
            }
            asm volatile("s_waitcnt lgkmcnt(0)" ::: "memory"); __builtin_amdgcn_wave_barrier();
#pragma unroll
            for (int mt = 0; mt < 2; ++mt) {
                float zz; asm volatile("v_mov_b32 %0, 0" : "=v"(zz)); f32x4 y4 = {zz, zz, zz, zz};
#pragma unroll
                for (int ks = 0; ks < 4; ++ks) { const bf16x8 a = *(const LAS bf16x8*)(xs + (16 * mt + hcol) * XS_PITCH + ks * 64 + q4 * 16);
                    y4 = __builtin_amdgcn_mfma_f32_16x16x32_bf16(a, cc[ks], y4, 0, 0, 0); }
#pragma unroll
                for (int r = 0; r < 4; ++r) { const int tok = 32 * tt + 16 * mt + 4 * q4 + r;
                    const float uv = bf2f(*(const LAS bf16*)(ut + tok * 32 + 2 * hcol));
                    *(LAS bf16*)(ot + tok * 32 + 2 * hcol) = f2bf16(pg8::gelu_tanh(y4[r] + dh * uv)); }
            }
            asm volatile("s_waitcnt lgkmcnt(0)" ::: "memory"); __builtin_amdgcn_wave_barrier();
        }
        { const v4u o0 = *(const LAS v4u*)(ot + tio), o1 = *(const LAS v4u*)(ot + tio + 1024);
          store16_wt(yout + (size_t)t0 * MIXW, o0); store16_wt(yout + (size_t)(t0 + 32) * MIXW, o1); }
        asm volatile("s_waitcnt lgkmcnt(0)" ::: "memory"); __builtin_amdgcn_wave_barrier();
    }
    asm volatile("s_waitcnt vmcnt(0)" ::: "memory");
    __syncthreads();
}
}

namespace lru {
constexpr int XT_PITCH = 144;
constexpr int OFF_XT = 0, XT_BYTES = 72 * XT_PITCH, OFF_GT = XT_BYTES, OFF_OT = OFF_GT + 2048, WAVE_BYTES = OFF_OT + 2048;
constexpr int OFF_AG = NWAVES * WAVE_BYTES;
constexpr int LRU_LDS = OFF_AG + 2 * 32 * 16 * 8;
static_assert(LRU_LDS <= RING_BYTES, "LRU LDS");
__device__ __forceinline__ void chain(int b, int n, int qd, const bf16* __restrict__ proj, bf16* __restrict__ ya,
                                      const float* __restrict__ conv_w, const float* __restrict__ conv_b, const float* __restrict__ wa, const float* __restrict__ ba,
                                      const float* __restrict__ wx, const float* __restrict__ bx, const float* __restrict__ lamp, char* lds) {
    int tid_ = threadIdx.x; asm volatile("" : "+v"(tid_));
    const int tid = tid_, wid = tid >> 6, lane = tid & 63, jc = lane & 15, q4 = lane >> 4, cp = lane & 31, hh = lane >> 5;
    const int cho = 64 * n + 16 * qd + jc;
    const int chp = 64 * n + 2 * cp;
    const float spl = log1pf(expf(-lamp[cho])), c8l = -8.0f * spl * LOG2E;
    const float bao = ba[cho], bxo = bx[cho];
    const float wo0 = conv_w[0 * MIXW + cho], wo1 = conv_w[1 * MIXW + cho], wo2 = conv_w[2 * MIXW + cho], wo3 = conv_w[3 * MIXW + cho], cbo = conv_b[cho];
    float wp[4][2], cbp[2];
#pragma unroll
    for (int e = 0; e < 2; ++e) { cbp[e] = conv_b[chp + e];
#pragma unroll
        for (int k = 0; k < 4; ++k) wp[k][e] = conv_w[k * MIXW + chp + e]; }
    bf16x8 Ba[2], Bx[2];
#pragma unroll
    for (int ks = 0; ks < 2; ++ks) { float va[8], vx[8];
#pragma unroll
        for (int j = 0; j < 8; ++j) { const size_t idx = ((size_t)n * 64 + 32 * ks + 8 * q4 + j) * 64 + 16 * qd + jc; va[j] = wa[idx]; vx[j] = wx[idx]; }
        v4u w0 = {cvtpk(va[0], va[1]), cvtpk(va[2], va[3]), cvtpk(va[4], va[5]), cvtpk(va[6], va[7])}; Ba[ks] = *reinterpret_cast<bf16x8*>(&w0);
        v4u w1 = {cvtpk(vx[0], vx[1]), cvtpk(vx[2], vx[3]), cvtpk(vx[4], vx[5]), cvtpk(vx[6], vx[7])}; Bx[ks] = *reinterpret_cast<bf16x8*>(&w1); }
    char* wl = lds + wid * WAVE_BYTES; char* xt = wl + OFF_XT; char* gt = wl + OFF_GT; char* ot = wl + OFF_OT;
    const bf16* xin = proj + (size_t)b * SEQ * LDP + COL_LX + 64 * n + 8 * (lane & 7);
    const bf16* gin = proj + ((size_t)b * SEQ + (lane >> 1)) * LDP + COL_LG + 64 * n + 16 * qd + 8 * (lane & 1);
    bf16* yout = ya + ((size_t)b * SEQ + (lane >> 1)) * MIXW + 64 * n + 16 * qd + 8 * (lane & 1);
    const int tio = (lane >> 1) * 32 + 16 * (lane & 1), xio = (lane >> 3) * XT_PITCH + 16 * (lane & 7);
    v4u px[9], pg0, pg1;
#define LRU_PREFETCH(T0) do { _Pragma("unroll") for (int j = 0; j < 9; ++j) { int t = (T0) - 3 + 8 * j + (lane >> 3); t = t > (T0) + 63 ? (T0) + 63 : t; \
            px[j] = (t >= 0) ? *(const v4u*)(xin + (size_t)t * LDP) : (v4u){0u, 0u, 0u, 0u}; } \
        pg0 = *(const v4u*)(gin + (size_t)(T0) * LDP); pg1 = *(const v4u*)(gin + (size_t)((T0) + 32) * LDP); } while (0)
    LRU_PREFETCH(64 * wid);
    float Cr = 0.f;
    for (int rd = 0; rd < 8; ++rd) {
        const int t0 = 64 * (8 * rd + wid);
#pragma unroll
        for (int j = 0; j < 9; ++j) *(LAS v4u*)(xt + 8 * j * XT_PITCH + xio) = px[j];
        *(LAS v4u*)(gt + tio) = pg0; *(LAS v4u*)(gt + tio + 1024) = pg1;
        if (rd < 7) LRU_PREFETCH(t0 + 512);
        asm volatile("s_waitcnt lgkmcnt(0)" ::: "memory"); __builtin_amdgcn_wave_barrier();
        float xcf[16];
        { float xw[19];
#pragma unroll
          for (int k = 0; k < 19; ++k) xw[k] = bf2f(*(const LAS bf16*)(xt + (16 * q4 + k) * XT_PITCH + 2 * (16 * qd + jc)));
#pragma unroll
          for (int k = 0; k < 16; ++k) xcf[k] = cbo + wo0 * xw[k] + wo1 * xw[k + 1] + wo2 * xw[k + 2] + wo3 * xw[k + 3]; }
        { unsigned rw[35];
#pragma unroll
          for (int k = 0; k < 35; ++k) rw[k] = *(const LAS unsigned*)(xt + (32 * hh + k) * XT_PITCH + 4 * cp);
          asm volatile("s_waitcnt lgkmcnt(0)" ::: "memory"); __builtin_amdgcn_wave_barrier();
#pragma unroll
          for (int k = 0; k < 32; ++k) {
              const float c0 = cbp[0] + wp[0][0] * pg8::bf_lo(rw[k]) + wp[1][0] * pg8::bf_lo(rw[k + 1]) + wp[2][0] * pg8::bf_lo(rw[k + 2]) + wp[3][0] * pg8::bf_lo(rw[k + 3]);
              const float c1 = cbp[1] + wp[0][1] * pg8::bf_hi(rw[k]) + wp[1][1] * pg8::bf_hi(rw[k + 1]) + wp[2][1] * pg8::bf_hi(rw[k + 2]) + wp[3][1] * pg8::bf_hi(rw[k + 3]);
              *(LAS unsigned*)(xt + (32 * hh + k + 3) * XT_PITCH + 4 * cp) = cvtpk(c0, c1); } }
        asm volatile("s_waitcnt lgkmcnt(0)" ::: "memory"); __builtin_amdgcn_wave_barrier();
        f32x4 ga[4], gx[4];
#pragma unroll
        for (int i = 0; i < 4; ++i) { const int tok = 16 * (jc >> 2) + 4 * i + (jc & 3);
            const bf16x8 a0 = *(const LAS bf16x8*)(xt + (tok + 3) * XT_PITCH + (0 + 8 * q4) * 2), a1 = *(const LAS bf16x8*)(xt + (tok + 3) * XT_PITCH + (32 + 8 * q4) * 2);
            float zz; asm volatile("v_mov_b32 %0, 0" : "=v"(zz)); f32x4 za = {zz, zz, zz, zz}, zx = {zz, zz, zz, zz};
            za = __builtin_amdgcn_mfma_f32_16x16x32_bf16(a0, Ba[0], za, 0, 0, 0); za = __builtin_amdgcn_mfma_f32_16x16x32_bf16(a1, Ba[1], za, 0, 0, 0);
            zx = __builtin_amdgcn_mfma_f32_16x16x32_bf16(a0, Bx[0], zx, 0, 0, 0); zx = __builtin_amdgcn_mfma_f32_16x16x32_bf16(a1, Bx[1], zx, 0, 0, 0);
            ga[i] = za; gx[i] = zx; }
        float hl[16], Pc[16];
        { float h = 0.f, P = 1.f;
#pragma unroll
          for (int k = 0; k < 16; ++k) { const float r = pg8::sigmoidf_(ga[k >> 2][k & 3] + bao), ig = pg8::sigmoidf_(gx[k >> 2][k & 3] + bxo);
              const float a = pg8::ex2(c8l * r); const float mult = __builtin_amdgcn_sqrtf(fmaxf(1.0f - a * a, 0.f));
              h = a * h + mult * (ig * xcf[k]); P = a * P; hl[k] = h; Pc[k] = P; }
          LAS float* ag = (LAS float*)(lds + OFF_AG) + (rd & 1) * (32 * 16 * 2);
          ag[((4 * wid + q4) * 16 + jc) * 2] = P; ag[((4 * wid + q4) * 16 + jc) * 2 + 1] = h; }
        __syncthreads();
        float cin = 0.f;
        { const LAS float* ag = (const LAS float*)(lds + OFF_AG) + (rd & 1) * (32 * 16 * 2); const int myseg = 4 * wid + q4; float c = Cr;
#pragma unroll 8
          for (int s = 0; s < 32; ++s) { cin = (s == myseg) ? c : cin; c = ag[(s * 16 + jc) * 2] * c + ag[(s * 16 + jc) * 2 + 1]; }
          Cr = c; }
#pragma unroll
        for (int k = 0; k < 16; ++k) { const int tok = 16 * q4 + k; const float h = hl[k] + Pc[k] * cin; const float gv = bf2f(*(const LAS bf16*)(gt + tok * 32 + 2 * jc));
            *(LAS bf16*)(ot + tok * 32 + 2 * jc) = f2bf16(h * gv); }
        asm volatile("s_waitcnt lgkmcnt(0)" ::: "memory"); __builtin_amdgcn_wave_barrier();
        { const v4u o0 = *(const LAS v4u*)(ot + tio), o1 = *(const LAS v4u*)(ot + tio + 1024);
          store16_wt(yout + (size_t)t0 * MIXW, o0); store16_wt(yout + (size_t)(t0 + 32) * MIXW, o1); }
        asm volatile("s_waitcnt lgkmcnt(0)" ::: "memory"); __builtin_amdgcn_wave_barrier();
    }
#undef LRU_PREFETCH
    asm volatile("s_waitcnt vmcnt(0)" ::: "memory");
    __syncthreads();
}
}

#ifndef MK_N_LAUNCHES
#define MK_N_LAUNCHES 1
#endif
#ifndef REP_PRO
#define REP_PRO 1
#endif
#ifndef REP_MIX
#define REP_MIX 1
#endif
#ifndef IN_REV
#define IN_REV 1
#endif
#ifndef REP_ATT
#define REP_ATT 1
#endif
#ifndef REP_S5
#define REP_S5 1
#endif
#ifndef REP_LRU
#define REP_LRU 1
#endif
#ifndef REP_G3
#define REP_G3 1
#endif
#ifndef REP_G6
#define REP_G6 1
#endif
#ifndef ALIGN_BR
#define ALIGN_BR true
#endif
#ifndef ALIGN_RES
#define ALIGN_RES true
#endif
#ifndef REP_RMS
#define REP_RMS 1
#endif
#ifndef REP_G0
#define REP_G0 1
#endif
#ifndef REP_G2
#define REP_G2 1
#endif
#ifndef REP_G5
#define REP_G5 1
#endif
#ifndef OPT_GROUPS
#define OPT_GROUPS 1
#endif
constexpr int N_PHASES = 1 + 9 * DEPTH;
constexpr bool ONE_LAUNCH = (MK_N_LAUNCHES == 1);
struct Args { const float* in[28]; float* out; unsigned char* ws; int ph_lo, ph_hi; };

__device__ __forceinline__ int opq_zero() { int z; asm volatile("s_mov_b32 %0, 0" : "=s"(z)); return z; }
__device__ __forceinline__ void group_barrier(unsigned* cnt, unsigned target, unsigned* xbar, volatile LAS unsigned* same_xcc) {
    asm volatile("s_waitcnt vmcnt(0)" ::: "memory");
    __syncthreads();
    if (threadIdx.x == 0) {
        if (*same_xcc == 0u) {
            __builtin_amdgcn_fence(__ATOMIC_RELEASE, "agent");
            asm volatile("s_waitcnt vmcnt(0)" ::: "memory"); }
        (void)xb_add(cnt, 1u);
        XB_SPIN(xb_ld(cnt) < target, xbar);
        __builtin_amdgcn_fence(__ATOMIC_ACQUIRE, "agent");
        asm volatile("s_waitcnt vmcnt(0)" ::: "memory");
    }
    __syncthreads();
}
__global__ void __launch_bounds__(NWAVES * 64, 2) fwd_kernel(Args args) {
    extern __shared__ __attribute__((aligned(16))) unsigned char lds[];
    const int tid = threadIdx.x;
    const int G = gridDim.x, bx = blockIdx.x;
    gu32* ctl = (gu32*)(args.ws + WS_CTL);
    for (int u = tid; u < (LDS_BYTES - LDSCTL_OFF) / 4; u += NWAVES * 64) ((LAS unsigned*)((LAS unsigned char*)lds + LDSCTL_OFF))[u] = 0u;
    __syncthreads();
    volatile LAS unsigned* MISC = (volatile LAS unsigned*)((LAS unsigned char*)lds + MISC_OFF);
    XcdBarrier bar; bar.bar = (unsigned*)(ctl + CW_BAR); bar.x = 0; bar.st = nullptr;
    if (ONE_LAUNCH) bar = xcd_barrier_post((unsigned*)(ctl + CW_BAR), MISC + 8);
    const int lo = args.ph_lo, hi = args.ph_hi;
    if (ONE_LAUNCH && OPT_GROUPS && G == 256 && tid == 0)
        __hip_atomic_store((unsigned*)(ctl + CW_GRPX) + 4 * (8 * (bx & 7) + ((bx >> 3) & 7)) + (bx >> 6), xb_xcc_id() + 1u, __ATOMIC_RELAXED, __HIP_MEMORY_SCOPE_AGENT);
#ifdef DBG_INV
    __builtin_amdgcn_fence(__ATOMIC_ACQUIRE, "agent"); asm volatile("s_waitcnt vmcnt(0)" ::: "memory"); __syncthreads();
#endif
#define IN(k) (lo <= (k) && (k) < hi)
#ifndef DBG_MHZ
#define DBG_MHZ 0
#endif
#ifdef DBG_T_LO
#define TSTAMP(k) do { int t_ = threadIdx.x; asm volatile("" : "+v"(t_)); if (((k) == DBG_T_LO || (k) == DBG_T_HI) && blockIdx.x == 0 && t_ == 0) { \
        if ((k) == DBG_T_LO) { const unsigned long long r_ = wall_clock64(), c_ = clock64(); MISC[18] = (unsigned)r_; MISC[19] = (unsigned)(r_ >> 32); MISC[16] = (unsigned)c_; MISC[17] = (unsigned)(c_ >> 32); } \
        if ((k) == DBG_T_HI) { const unsigned long long r0_ = ((unsigned long long)MISC[19] << 32) | MISC[18], c0_ = ((unsigned long long)MISC[17] << 32) | MISC[16]; \
            const unsigned long long dr_ = wall_clock64() - r0_, dc_ = clock64() - c0_; MISC[21] = DBG_MHZ ? (unsigned)(dc_ * 10000ull / (dr_ ? dr_ : 1ull)) : (unsigned)dr_; } } } while (0)
#else
#define TSTAMP(k) do { } while (0)
#endif
#ifdef OPT_BAR2
#define SEAM(k) do { if (ONE_LAUNCH && IN(k) && IN((k) + 1)) { xcd_barrier(bar); xcd_barrier(bar); } } while (0)
#else
#define SEAM(k) do { if (ONE_LAUNCH && IN(k) && IN((k) + 1)) xcd_barrier(bar); } while (0)
#endif

    const int NGW = G * NWAVES;
#define GSEAM(k, s) do { if (ONE_LAUNCH && IN(k) && IN((k) + 1)) { if (OPT_GROUPS && G == 256) group_barrier((unsigned*)(ctl + CW_GRP) + 64 * (8 * (bx & 7) + ((bx >> 3) & 7)), 4u * (unsigned)(5 * l + (s) + 1), bar.bar, MISC + 24); else xcd_barrier(bar); } } while (0)
#define LANEW() int tl_ = threadIdx.x; asm volatile("" : "+v"(tl_)); const int lane = tl_ & 63, wave = __builtin_amdgcn_readfirstlane(tl_ >> 6), gw = bx * NWAVES + wave; (void)lane; (void)gw;
#define OPQ(p) ((p) + opq_zero())
#define PTRS() unsigned char* ws = OPQ(args.ws); float* X = OPQ(args.out); const float* x_in = OPQ(args.in[0]); \
    bf16* Hn = (bf16*)(ws + WS_H); bf16* PROJ = (bf16*)(ws + WS_PROJ); bf16* HID = (bf16*)(ws + WS_HID); \
    bf16* YA = (bf16*)(ws + WS_YA); bf16* YB = (bf16*)(ws + WS_YB); bf16* YC = (bf16*)(ws + WS_YC); bf16* PB = (bf16*)(ws + WS_PB); bf16* SB = (bf16*)(ws + WS_SB); \
    float* PAR = (float*)(ws + WS_PAR); const float* PL = PAR + (size_t)l * PAR_STRIDE; float* PART = (float*)(ws + WS_SB); (void)PART; \
    (void)X; (void)x_in; (void)Hn; (void)PROJ; (void)HID; (void)YA; (void)YB; (void)YC; (void)PB; (void)SB; (void)PL;

    LAS float* RINV = (LAS float*)((LAS unsigned char*)lds + RINV_OFF);
#define RINV_PASS() do { int t_ = threadIdx.x; asm volatile("" : "+v"(t_)); if (t_ < 256) { const size_t row_ = (size_t)256 * (8 * (bx & 7) + ((bx >> 3) & 7)) + t_; float s_ = 0.f; \
        _Pragma("unroll") for (int pn_ = 0; pn_ < 8; ++pn_) { const f32x4 p_ = *(const GAS f32x4*)(PART + ((size_t)pn_ * M + row_) * 4); s_ += (p_.x + p_.y) + (p_.z + p_.w); } \
        RINV[t_] = 1.0f / sqrtf(s_ * (1.0f / DM) + NORM_EPS); } __syncthreads(); } while (0)

    TSTAMP(0);
#ifndef NO_PRO
    if (IN(0)) for (int rep_ = 0; rep_ < REP_PRO; ++rep_) {
        const int l = 0; PTRS(); LANEW();
        LAS float* scr = (LAS float*)((LAS unsigned char*)lds + RING_OFF + wave * 16384);
        constexpr int I_IN = (DM / 64) * (INW / 32), I_BR = (MIXW / 64) * (DM / 32), I_OUT = (DM / 64) * (DM / 32), I_G = (DM / 64) * (FFH / 32), I_DN = (FFH / 64) * (DM / 32);
        constexpr int I_LAYER = I_IN + 4 * I_BR + I_OUT + 2 * I_G + I_DN;
        for (int it = gw; it < DEPTH * I_LAYER; it += NGW) {
            const int l = it / I_LAYER; int r = it % I_LAYER;
            if (r < I_IN) { transpose_item(args.in[2] + (size_t)l * DM * INW, DM, INW, (bf16*)(ws + WS_WIN) + (size_t)l * INW * DM, RowId{}, scr, r, lane, args.in[1] + (size_t)l * DM); continue; } r -= I_IN;
            if (r < 2 * I_BR) { const int br = r / I_BR;
                transpose_item(args.in[21] + ((size_t)l * 3 + br) * MIXW * DM, MIXW, DM, (bf16*)(ws + WS_WBR) + ((size_t)l * 4 + br) * DM * MIXW, RowId{}, scr, r % I_BR, lane); continue; } r -= 2 * I_BR;
            if (r < I_BR) { transpose_item(args.in[21] + ((size_t)l * 3 + 2) * MIXW * DM, MIXW, DM, (bf16*)(ws + WS_WBR) + ((size_t)l * 4 + 2) * DM * MIXW, RowGU{0}, scr, r, lane); continue; } r -= I_BR;
            if (r < I_BR) { transpose_item(args.in[20] + (size_t)l * MIXW * DM, MIXW, DM, (bf16*)(ws + WS_WBR) + ((size_t)l * 4 + 2) * DM * MIXW, RowGU{1}, scr, r, lane); continue; } r -= I_BR;
            if (r < I_OUT) { transpose_item(args.in[22] + (size_t)l * DM * DM, DM, DM, (bf16*)(ws + WS_WOUT) + (size_t)l * DM * DM, RowId{}, scr, r, lane); continue; } r -= I_OUT;
            if (r < I_G) { transpose_item(args.in[24] + (size_t)l * DM * FFH, DM, FFH, (bf16*)(ws + WS_WGU) + (size_t)l * 2 * FFH * DM, RowGU{0}, scr, r, lane, args.in[23] + (size_t)l * DM); continue; } r -= I_G;
            if (r < I_G) { transpose_item(args.in[25] + (size_t)l * DM * FFH, DM, FFH, (bf16*)(ws + WS_WGU) + (size_t)l * 2 * FFH * DM, RowGU{1}, scr, r, lane, args.in[23] + (size_t)l * DM); continue; } r -= I_G;
            transpose_item(args.in[26] + (size_t)l * FFH * DM, FFH, DM, (bf16*)(ws + WS_WDN) + (size_t)l * DM * FFH, RowId{}, scr, r, lane);
        }
        { const int gt = bx * (NWAVES * 64) + tl_, gs = G * (NWAVES * 64);
#define PCOPY(k, cnt, off) for (int i = gt; i < DEPTH * (cnt); i += gs) __hip_atomic_store(PAR + (size_t)(i / (cnt)) * PAR_STRIDE + (off) + (i % (cnt)), args.in[k][i], __ATOMIC_RELAXED, __HIP_MEMORY_SCOPE_AGENT)
          PCOPY(1, 2048, P_GMIX); PCOPY(3, 6144, P_GBIAS); PCOPY(4, 4096, P_CONVW); PCOPY(5, 1024, P_CONVB); PCOPY(7, 1024, P_BA); PCOPY(9, 1024, P_BX); PCOPY(10, 1024, P_LAM); PCOPY(11, 2056, P_RELB);
          PCOPY(12, 4096, P_ARE); PCOPY(13, 4096, P_AIM); PCOPY(18, 1024, P_D); PCOPY(19, 64, P_LOGSTEP); PCOPY(23, 2048, P_GFFN); PCOPY(6, 65536, P_WA); PCOPY(8, 65536, P_WX);
          PCOPY(14, 65536, P_BRE); PCOPY(15, 65536, P_BIM); PCOPY(16, 65536, P_CRE); PCOPY(17, 65536, P_CIM);
#undef PCOPY
          for (int i = gt; i < 2048; i += gs) __hip_atomic_store(PAR + P_GFIN + i, args.in[27][i], __ATOMIC_RELAXED, __HIP_MEMORY_SCOPE_AGENT); }
        for (int m = gw; m < M; m += NGW) row_bf16_ss(x_in + (size_t)m * DM, Hn + (size_t)m * DM, PART, m, lane);
    }
#endif
    SEAM(0);
    if (ONE_LAUNCH && OPT_GROUPS && G == 256) {
        int t_ = threadIdx.x; asm volatile("" : "+v"(t_));
        if (t_ == 0) { unsigned* gx = (unsigned*)(ctl + CW_GRPX) + 4 * (8 * (bx & 7) + ((bx >> 3) & 7)); const unsigned a0 = xb_ld(gx), a1 = xb_ld(gx + 1), a2 = xb_ld(gx + 2), a3 = xb_ld(gx + 3);
            MISC[24] = (a0 != 0u && a0 == a1 && a0 == a2 && a0 == a3) ? 1u : 0u; } }
#ifdef DBG_G0NULL
    { const int l = 0; PTRS();
      if (DBG_G0NULL == 1) { pg8::Gemm g{Hn, (const bf16*)(ws + WS_WIN), M, INW, DM}; pg8::StaticOrder S; S.init(M, INW, G, bx); pg8::EpiNull E2{}; pg8::gemm_phase<pg8::EpiNull, pg8::StaticOrder, true, true>((LAS unsigned char*)lds + RING_OFF, g, S, E2); }
      else { pg8::Gemm g{Hn, (const bf16*)(ws + WS_WGU), M, 2 * FFH, DM}; pg8::StaticOrder S; S.init(M, 2 * FFH, G, bx); pg8::EpiNull E2{}; pg8::gemm_phase<pg8::EpiNull, pg8::StaticOrder, true, true>((LAS unsigned char*)lds + RING_OFF, g, S, E2); } }
#endif

    for (int l = 0; l < DEPTH; ++l) {
        const int P = 1 + 9 * l;
        TSTAMP(P + 0);
#ifndef NO_G0
        if (IN(P + 0)) for (int rep_ = 0; rep_ < REP_G0; ++rep_) {
            PTRS();
            pg8::Gemm g{Hn, (const bf16*)(ws + WS_WIN) + (size_t)l * INW * DM, M, INW, DM}; pg8::StaticOrder S; S.init(M, INW, G, bx); S.rev = IN_REV;
            RINV_PASS();
            pg8::EpiIn E{PROJ, PL + P_GBIAS, RINV};
            pg8::gemm_phase<pg8::EpiIn, pg8::StaticOrder, true, true>((LAS unsigned char*)lds + RING_OFF, g, S, E);
#ifdef DBG_G0ALT
            { pg8::EpiSwiglu E2{YA, RINV}; pg8::gemm_phase<pg8::EpiSwiglu, pg8::StaticOrder, true, true>((LAS unsigned char*)lds + RING_OFF, g, S, E2); }
#endif
        }
#endif
        SEAM(P + 0);
        TSTAMP(P + 1);
        if (IN(P + 1)) for (int rep_ = 0; rep_ < REP_MIX; ++rep_) {
            PTRS();
#if defined(NO_ATT) || defined(NO_S5) || defined(NO_LRU)
            { LANEW(); v4u z = {0u, 0u, 0u, 0u};
              for (size_t i = (size_t)bx * 512 + tl_; i < (size_t)M * MIXW / 8; i += (size_t)G * 512) {
#ifdef NO_ATT
                  ((v4u*)YB)[i] = z;
#endif
#ifdef NO_S5
                  ((v4u*)YC)[i] = z;
#endif
#ifdef NO_LRU
                  ((v4u*)YA)[i] = z;
#endif
              } }
#endif
#ifndef NO_ATT
            for (int rr_ = 0; rr_ < REP_ATT; ++rr_)
            for (int i = bx; i < 512; i += G) {
                const int j = i & 255, kq = j >> 3, bh = 8 * (kq >> 3) + (j & 7), qb = (i < 256) ? 15 - (kq & 7) : (kq & 7);
                att::attn_unit(bh >> 3, bh & 7, qb, PROJ, YB, PL + P_RELB + (bh & 7) * 257, (char*)lds + RING_OFF);
            }
#endif
            __syncthreads();
            TSTAMP(200 + 8 * l + 0);
#ifndef NO_S5
            for (int rr_ = 0; rr_ < REP_S5; ++rr_)
            for (int i = bx; i < 256; i += G)
                s5::chain((((i >> 5) * 8 + (i & 7)) >> 4), 4 * ((((i >> 5) * 8 + (i & 7))) & 15) + ((i >> 3) & 3), PROJ, YC,     PL + P_ARE, PL + P_AIM, PL + P_BRE, PL + P_BIM,
                          PL + P_CRE, PL + P_CIM, PL + P_D, PL + P_LOGSTEP, (char*)lds + RING_OFF);
#endif
            TSTAMP(200 + 8 * l + 1);
#ifndef NO_LRU
            for (int rr_ = 0; rr_ < REP_LRU; ++rr_)
            for (int i = bx; i < 256; i += G)
                lru::chain((((i >> 5) * 8 + (i & 7)) >> 4), (((i >> 5) * 8 + (i & 7))) & 15, (i >> 3) & 3, PROJ, YA,     PL + P_CONVW, PL + P_CONVB, PL + P_WA, PL + P_BA,
                           PL + P_WX, PL + P_BX, PL + P_LAM, (char*)lds + RING_OFF);
#endif
        }
        SEAM(P + 1);
        TSTAMP(P + 2);
#ifndef NO_G2
        if (IN(P + 2)) {
            PTRS();
            pg8::Gemm g{YC, (const bf16*)(ws + WS_WBR) + ((size_t)l * 4 + 2) * DM * MIXW, M, 2 * DM, MIXW}; pg8::StaticOrder S; S.init(M, 2 * DM, G, bx);
            pg8::EpiGlu E{PROJ, PB};
            pg8::gemm_phase<pg8::EpiGlu, pg8::StaticOrder, true, true>((LAS unsigned char*)lds + RING_OFF, g, S, E);
        }
#endif
        GSEAM(P + 2, 0);
        TSTAMP(P + 3);
#ifndef NO_G2
        if (IN(P + 3)) {
            PTRS();
            const bf16* WB = (const bf16*)(ws + WS_WBR) + (size_t)l * 4 * DM * MIXW;
            pg8::StaticOrder S; S.init(M, DM, G, bx);
            { pg8::Gemm g{YA, WB + 0 * (size_t)DM * MIXW, M, DM, MIXW}; pg8::EpiBrAcc E{PROJ, PB, 0}; pg8::gemm_phase<pg8::EpiBrAcc, pg8::StaticOrder, true, true>((LAS unsigned char*)lds + RING_OFF, g, S, E); }
            { pg8::Gemm g{YB, WB + 1 * (size_t)DM * MIXW, M, DM, MIXW}; pg8::EpiBrAcc E{PROJ, PB, 1}; pg8::gemm_phase<pg8::EpiBrAcc, pg8::StaticOrder, true, true>((LAS unsigned char*)lds + RING_OFF, g, S, E); }
        }
#endif
        GSEAM(P + 3, 1);
        TSTAMP(P + 4);
#ifndef NO_G3
        if (IN(P + 4)) {
            PTRS();
            pg8::Gemm g{PB, (const bf16*)(ws + WS_WOUT) + (size_t)l * DM * DM, M, DM, DM}; pg8::StaticOrder S; S.init(M, DM, G, bx);
            for (int rep_ = 1; rep_ < REP_G3; ++rep_) { pg8::EpiRes E2{l == 0 ? x_in : (const float*)X, (float*)PROJ, YA, (float*)YB}; pg8::gemm_phase<pg8::EpiRes, pg8::StaticOrder, ALIGN_RES, true>((LAS unsigned char*)lds + RING_OFF, g, S, E2); }
            pg8::EpiRes E{l == 0 ? x_in : (const float*)X, X, Hn, PART};
            pg8::gemm_phase<pg8::EpiRes, pg8::StaticOrder, ALIGN_RES, true>((LAS unsigned char*)lds + RING_OFF, g, S, E);
        }
#endif
        GSEAM(P + 4, 2);
        TSTAMP(P + 6);
#ifndef NO_G5
#ifdef DBG_CLK
        if (l == 1 && bx == 0 && tid == 0) { const unsigned long long c_ = clock64(), r_ = wall_clock64(); MISC[16] = (unsigned)c_; MISC[17] = (unsigned)(c_ >> 32); MISC[18] = (unsigned)r_; MISC[19] = (unsigned)(r_ >> 32); }
#endif
        if (IN(P + 6)) for (int rep_ = 0; rep_ < REP_G5; ++rep_) {
            PTRS();
            pg8::Gemm g{Hn, (const bf16*)(ws + WS_WGU) + (size_t)l * 2 * FFH * DM, M, 2 * FFH, DM}; pg8::StaticOrder S; S.init(M, 2 * FFH, G, bx);
            RINV_PASS();
            pg8::EpiSwiglu E{HID, RINV};
            pg8::gemm_phase<pg8::EpiSwiglu, pg8::StaticOrder, true, true>((LAS unsigned char*)lds + RING_OFF, g, S, E);
        }
#endif
#ifdef DBG_CLK
        if (l == 1 && bx == 0 && tid == 0) { const unsigned long long ck0 = ((unsigned long long)MISC[17] << 32) | MISC[16], rt0 = ((unsigned long long)MISC[19] << 32) | MISC[18];
            const unsigned long long dck = clock64() - ck0, drt = wall_clock64() - rt0;
            MISC[20] = (unsigned)(dck * 100ull / (drt ? drt : 1ull)); }
#endif
        GSEAM(P + 6, 3);
        TSTAMP(P + 7);
#ifndef NO_G6
        if (IN(P + 7)) {
            PTRS();
            pg8::Gemm g{HID, (const bf16*)(ws + WS_WDN) + (size_t)l * DM * FFH, M, DM, FFH}; pg8::StaticOrder S; S.init(M, DM, G, bx);
            for (int rep_ = 1; rep_ < REP_G6; ++rep_) { pg8::EpiRes E2{X, (float*)PB, YA, (float*)YB}; pg8::gemm_phase<pg8::EpiRes, pg8::StaticOrder, ALIGN_RES, true>((LAS unsigned char*)lds + RING_OFF, g, S, E2); }
            pg8::EpiRes E{X, X, Hn, PART};
            pg8::gemm_phase<pg8::EpiRes, pg8::StaticOrder, ALIGN_RES, true>((LAS unsigned char*)lds + RING_OFF, g, S, E);
        }
#endif
        GSEAM(P + 7, 4);
        TSTAMP(P + 8);
        if (IN(P + 8) && l + 1 == DEPTH) {
            PTRS(); LANEW();
            if (OPT_GROUPS && ONE_LAUNCH && G == 256) { const int m0 = 256 * (8 * (bx & 7) + ((bx >> 3) & 7)) + 64 * (bx >> 6) + 8 * wave;
                for (int k = 0; k < 8; ++k) rms_row_f32(X + (size_t)(m0 + k) * DM, PAR + P_GFIN, lane); }
            else { for (int m = gw; m < M; m += NGW) rms_row_f32(X + (size_t)m * DM, PAR + P_GFIN, lane); }
        }
    }
    TSTAMP(N_PHASES);
#ifdef DBG_T_LO
    { int t_ = threadIdx.x; asm volatile("" : "+v"(t_)); if (blockIdx.x == 0 && t_ == 0) { const unsigned long long t0 = wall_clock64(); while (wall_clock64() - t0 < (unsigned long long)MISC[21]) __builtin_amdgcn_s_sleep(8); } }
#endif
#ifdef DBG_CLK
    if (bx == 0 && tid == 0) { const unsigned long long t0 = wall_clock64(); while (wall_clock64() - t0 < (unsigned long long)MISC[20] * 100ull) __builtin_amdgcn_s_sleep(8); }
#endif
#undef IN
#undef SEAM
}

#ifdef DBG_DUMP
__global__ void dbg_dump(const bf16* src, float* out) {
    for (size_t i = (size_t)blockIdx.x * 256 + threadIdx.x; i < (size_t)M * DM; i += (size_t)gridDim.x * 256) { const size_t m = i / DM, c = i % DM; out[i] = bf2f(src[m * DBG_PITCH + (c % DBG_PITCH)]); }
}
#endif
extern "C" void kernel_launch(void* const* d_in, const int* in_sizes, int n_in, void* d_out, int out_size, void* d_ws, size_t ws_size, hipStream_t stream) {
    static int grid = 0;
    if (grid == 0) {
        if (n_in != 28 || in_sizes[0] != M * DM || out_size != M * DM || ws_size < WS_END) {
            fprintf(stderr, "kernel_launch: built for 28 inputs, x/out of %d floats, >= %zu bytes of workspace; got n_in %d, in0 %d, out %d, ws %zu; nothing launched\n", M * DM, (size_t)WS_END, n_in, n_in > 0 ? in_sizes[0] : -1, out_size, ws_size);
            grid = -1; return; }
        int dev = 0, cus = 0, per_cu = 0;
        if (hipGetDevice(&dev) != hipSuccess || hipDeviceGetAttribute(&cus, hipDeviceAttributeMultiprocessorCount, dev) != hipSuccess) { fprintf(stderr, "kernel_launch: device query failed\n"); grid = -1; return; }
        if (hipFuncSetAttribute((const void*)fwd_kernel, hipFuncAttributeMaxDynamicSharedMemorySize, LDS_BYTES) != hipSuccess) { fprintf(stderr, "kernel_launch: hipFuncSetAttribute failed\n"); grid = -1; return; }
        if (hipOccupancyMaxActiveBlocksPerMultiprocessor(&per_cu, (const void*)fwd_kernel, NWAVES * 64, LDS_BYTES) != hipSuccess || per_cu < 1)
            fprintf(stderr, "kernel_launch: note: occupancy query reports %d workgroups per CU\n", per_cu);
        (void)hipGetLastError();
        grid = cus;
        if (grid > 256) grid = 256;
        if (grid != 256) { fprintf(stderr, "kernel_launch: this build maps row panels to workgroups for 256 CUs; found %d; nothing launched\n", cus); grid = -1; return; }
    }
    if (grid < 0) return;
    if (hipMemsetAsync((char*)d_ws + WS_CTL, 0, CTL_ZERO_BYTES, stream) != hipSuccess) { fprintf(stderr, "kernel_launch: memset failed\n"); return; }
    Args a{};
    for (int i = 0; i < 28; ++i) a.in[i] = (const float*)d_in[i];
    a.out = (float*)d_out; a.ws = (unsigned char*)d_ws;
    if (ONE_LAUNCH) {
        a.ph_lo = 0; a.ph_hi = N_PHASES;
        hipLaunchKernelGGL(fwd_kernel, dim3(grid), dim3(NWAVES * 64), LDS_BYTES, stream, a);
    } else {
#ifdef DBG_STOP
        for (int p = 0; p < DBG_STOP; ++p) { a.ph_lo = p;
#else
        for (int p = 0; p < N_PHASES; ++p) { a.ph_lo = p;
#endif
         a.ph_hi = p + 1; hipLaunchKernelGGL(fwd_kernel, dim3(grid), dim3(NWAVES * 64), LDS_BYTES, stream, a); }
#ifdef DBG_DUMP
        hipLaunchKernelGGL(dbg_dump, dim3(1024), dim3(256), 0, stream, (const bf16*)((unsigned char*)d_ws + DBG_DUMP), (float*)d_out);
#endif
    }
    const hipError_t le = hipPeekAtLastError();
    if (le != hipSuccess) fprintf(stderr, "kernel_launch: launch failed: %s\n", hipGetErrorName(le));
}
```
